# Optimizing an MI355X kernel written in HIP

```python
import jax
import jax.numpy as jnp
from jax import lax
import numpy as np

D_MODEL = 2048
BATCH = 8
SEQ = 2048
DEPTH = 2

GRID_W = 64
CTX_LEN = 256
HEAD_DIM = 128
ROPE_THETA = 10000.0
EPS = 1e-6
Q_BLOCK = 128
N_MOD = 9
D_FF = 5632

CONV_CHANNELS = D_MODEL // 2
GQA_HEADS = (D_MODEL // 2) // HEAD_DIM
GQA_KV_HEADS = 2
GQA_GROUP = GQA_HEADS // GQA_KV_HEADS
HYB_IN = 3 * CONV_CHANNELS + (GQA_HEADS + 2 * GQA_KV_HEADS) * HEAD_DIM
HYB_OUT = CONV_CHANNELS + GQA_HEADS * HEAD_DIM

MLA_HEADS = D_MODEL // HEAD_DIM
MLA_Q_RANK = 768
MLA_KV_RANK = 512
MLA_NOPE = 128
MLA_ROPE = 64
MLA_V = 128
MLA_DOWN = MLA_Q_RANK + MLA_KV_RANK + MLA_ROPE
MLA_SCALE = (MLA_NOPE + MLA_ROPE) ** -0.5

N_EVEN = (DEPTH + 1) // 2
N_ODD = DEPTH // 2

kernel_name = 'hybrid_conv_gqa_mla_macaron_prefix_dit'


def rms_norm(x, g):
    xf = x.astype(jnp.float32)
    y = xf * lax.rsqrt(jnp.mean(xf * xf, axis=-1, keepdims=True) + EPS)
    return (y * g.astype(jnp.float32)).astype(x.dtype)


def modulated_norm(h, g, shift, scale):
    return rms_norm(h, g) * (1 + scale) + shift


def swiglu(h, w_gate, w_up, w_down):
    return (jax.nn.silu(h @ w_gate) * (h @ w_up)) @ w_down


def axial_rope_tables(n_tok, dim, dtype):
    n_rows = n_tok // GRID_W
    row = jnp.repeat(jnp.arange(n_rows), GRID_W).astype(jnp.float32)
    col = jnp.tile(jnp.arange(GRID_W), n_rows).astype(jnp.float32)
    half = dim // 2
    inv = 1.0 / (ROPE_THETA ** (jnp.arange(0, half, 2, dtype=jnp.float32) / half))
    ang = jnp.concatenate([row[:, None] * inv, col[:, None] * inv], axis=-1)
    return jnp.cos(ang).astype(dtype), jnp.sin(ang).astype(dtype)


def apply_rope(x, cos, sin):
    xp = x.reshape(*x.shape[:-1], x.shape[-1] // 2, 2)
    x0, x1 = xp[..., 0], xp[..., 1]
    return jnp.stack([x0 * cos - x1 * sin, x0 * sin + x1 * cos], axis=-1).reshape(x.shape)


def short_conv3(u, w):
    up = jnp.pad(u, ((0, 0), (1, 1), (0, 0)))
    return up[:, :-2] * w[0] + up[:, 1:-1] * w[1] + up[:, 2:] * w[2]


def sweep_query_blocks(fn, *qs):
    b, t = qs[0].shape[:2]
    nb = t // Q_BLOCK
    blocks = tuple(jnp.moveaxis(q.reshape(b, nb, Q_BLOCK, *q.shape[2:]), 1, 0) for q in qs)
    out = lax.map(lambda qb: fn(*qb), blocks)
    out = jnp.moveaxis(out, 0, 1)
    return out.reshape(b, t, *out.shape[3:])


def gqa_attend(q, k, v):
    s = jnp.einsum('bqgrd,bkgd->bgrqk', q, k).astype(jnp.float32) * (HEAD_DIM ** -0.5)
    p = jax.nn.softmax(s, axis=-1).astype(v.dtype)
    return jnp.einsum('bgrqk,bkgd->bqgrd', p, v)


def mla_attend(qn, qr, kn, kr, v):
    s = (jnp.einsum('bqhd,bkhd->bhqk', qn, kn)
         + jnp.einsum('bqhr,bkr->bhqk', qr, kr)).astype(jnp.float32) * MLA_SCALE
    p = jax.nn.softmax(s, axis=-1).astype(v.dtype)
    return jnp.einsum('bhqk,bkhd->bqhd', p, v)


def conv_attn_mixer(hc, hl, w_in, conv_w, q_norm, k_norm, w_out, cos, sin, need_ctx):
    splits = [CONV_CHANNELS, 2 * CONV_CHANNELS, 3 * CONV_CHANNELS,
              3 * CONV_CHANNELS + GQA_HEADS * HEAD_DIM,
              3 * CONV_CHANNELS + (GQA_HEADS + GQA_KV_HEADS) * HEAD_DIM]

    def project(h):
        b, t = h.shape[:2]
        gate_b, gate_c, u, q, k, v = jnp.split(h @ w_in, splits, axis=-1)
        conv_out = gate_b * short_conv3(gate_c * u, conv_w)
        q = rms_norm(q.reshape(b, t, GQA_KV_HEADS, GQA_GROUP, HEAD_DIM), q_norm)
        k = rms_norm(k.reshape(b, t, GQA_KV_HEADS, HEAD_DIM), k_norm)
        v = v.reshape(b, t, GQA_KV_HEADS, HEAD_DIM)
        return conv_out, q, k, v

    b, t = hl.shape[:2]
    conv_l, ql, kl, vl = project(hl)
    ql = apply_rope(ql, cos[:, None, None], sin[:, None, None])
    kl = apply_rope(kl, cos[:, None], sin[:, None])
    conv_c, qc, kc, vc = project(hc)
    k_all = jnp.concatenate([kc, kl], axis=1)
    v_all = jnp.concatenate([vc, vl], axis=1)
    att_l = sweep_query_blocks(lambda qb: gqa_attend(qb, k_all, v_all), ql)
    out_l = jnp.concatenate([conv_l, att_l.reshape(b, t, -1)], axis=-1) @ w_out
    out_c = None
    if need_ctx:
        att_c = gqa_attend(qc, kc, vc)
        out_c = jnp.concatenate([conv_c, att_c.reshape(hc.shape[0], hc.shape[1], -1)], axis=-1) @ w_out
    return out_c, out_l


def mla_mixer(hc, hl, w_down, q_norm, kv_norm, w_uq, w_ukv, w_o, cos, sin, need_ctx):
    def project(h):
        b, t = h.shape[:2]
        cq, ckv, kr = jnp.split(h @ w_down, [MLA_Q_RANK, MLA_Q_RANK + MLA_KV_RANK], axis=-1)
        q = (rms_norm(cq, q_norm) @ w_uq).reshape(b, t, MLA_HEADS, MLA_NOPE + MLA_ROPE)
        kv = (rms_norm(ckv, kv_norm) @ w_ukv).reshape(b, t, MLA_HEADS, MLA_NOPE + MLA_V)
        qn, qr = jnp.split(q, [MLA_NOPE], axis=-1)
        kn, v = jnp.split(kv, [MLA_NOPE], axis=-1)
        return qn, qr, kn, kr, v

    b, t = hl.shape[:2]
    qnl, qrl, knl, krl, vl = project(hl)
    qrl = apply_rope(qrl, cos[:, None], sin[:, None])
    krl = apply_rope(krl, cos, sin)
    qnc, qrc, knc, krc, vc = project(hc)
    kn_all = jnp.concatenate([knc, knl], axis=1)
    kr_all = jnp.concatenate([krc, krl], axis=1)
    v_all = jnp.concatenate([vc, vl], axis=1)
    att_l = sweep_query_blocks(lambda qn_b, qr_b: mla_attend(qn_b, qr_b, kn_all, kr_all, v_all), qnl, qrl)
    out_l = att_l.reshape(b, t, -1) @ w_o
    out_c = None
    if need_ctx:
        out_c = mla_attend(qnc, qrc, knc, krc, vc).reshape(hc.shape[0], hc.shape[1], -1) @ w_o
    return out_c, out_l


def setup_inputs(seed: int = 0) -> dict:
    key = jax.random.key(seed)
    ks = iter(jax.random.split(key, 32))
    f32 = jnp.float32

    def nrm(shape, fan_in, g=1.0):
        return g * fan_in ** -0.5 * jax.random.normal(next(ks), shape, f32)

    def gain(shape):
        return 1.0 + 0.05 * jax.random.normal(next(ks), shape, f32)

    return {
        'x': jax.random.normal(next(ks), (BATCH, SEQ, D_MODEL), f32),
        'c': jax.random.normal(next(ks), (BATCH, D_MODEL), f32),
        'ctx': jax.random.normal(next(ks), (BATCH, CTX_LEN, D_MODEL), f32),
        'c_ctx': jax.random.normal(next(ks), (D_MODEL,), f32),
        'mod_w': nrm((DEPTH, D_MODEL, N_MOD * D_MODEL), D_MODEL, 0.5),
        'mod_b': 0.02 * jax.random.normal(next(ks), (DEPTH, N_MOD * D_MODEL), f32),
        'norm_ffn1': gain((DEPTH, D_MODEL)),
        'norm_mix': gain((DEPTH, D_MODEL)),
        'norm_ffn2': gain((DEPTH, D_MODEL)),
        'ffn1_w_gate': nrm((DEPTH, D_MODEL, D_FF), D_MODEL),
        'ffn1_w_up': nrm((DEPTH, D_MODEL, D_FF), D_MODEL),
        'ffn1_w_down': nrm((DEPTH, D_FF, D_MODEL), D_FF),
        'ffn2_w_gate': nrm((DEPTH, D_MODEL, D_FF), D_MODEL),
        'ffn2_w_up': nrm((DEPTH, D_MODEL, D_FF), D_MODEL),
        'ffn2_w_down': nrm((DEPTH, D_FF, D_MODEL), D_FF),
        'hyb_w_in': nrm((N_EVEN, D_MODEL, HYB_IN), D_MODEL),
        'hyb_conv_w': nrm((N_EVEN, 3, CONV_CHANNELS), 3),
        'hyb_q_norm': gain((N_EVEN, HEAD_DIM)),
        'hyb_k_norm': gain((N_EVEN, HEAD_DIM)),
        'hyb_w_out': nrm((N_EVEN, HYB_OUT, D_MODEL), HYB_OUT),
        'mla_w_down': nrm((N_ODD, D_MODEL, MLA_DOWN), D_MODEL),
        'mla_q_norm': gain((N_ODD, MLA_Q_RANK)),
        'mla_kv_norm': gain((N_ODD, MLA_KV_RANK)),
        'mla_w_uq': nrm((N_ODD, MLA_Q_RANK, MLA_HEADS * (MLA_NOPE + MLA_ROPE)), MLA_Q_RANK),
        'mla_w_ukv': nrm((N_ODD, MLA_KV_RANK, MLA_HEADS * (MLA_NOPE + MLA_V)), MLA_KV_RANK),
        'mla_w_o': nrm((N_ODD, MLA_HEADS * MLA_V, D_MODEL), MLA_HEADS * MLA_V),
        'final_norm': gain((D_MODEL,)),
    }


def reference(x, c, ctx, c_ctx, mod_w, mod_b, norm_ffn1, norm_mix, norm_ffn2,
              ffn1_w_gate, ffn1_w_up, ffn1_w_down, ffn2_w_gate, ffn2_w_up, ffn2_w_down,
              hyb_w_in, hyb_conv_w, hyb_q_norm, hyb_k_norm, hyb_w_out,
              mla_w_down, mla_q_norm, mla_kv_norm, mla_w_uq, mla_w_ukv, mla_w_o, final_norm):
    n_lat = x.shape[1]
    cos_a, sin_a = axial_rope_tables(n_lat, HEAD_DIM, x.dtype)
    cos_m, sin_m = axial_rope_tables(n_lat, MLA_ROPE, x.dtype)
    silu_c = jax.nn.silu(c)
    silu_cc = jax.nn.silu(c_ctx)
    xl, xc = x, ctx
    for layer in range(DEPTH):
        need_ctx = layer < DEPTH - 1
        m_l = jnp.split((silu_c @ mod_w[layer] + mod_b[layer])[:, None, :], N_MOD, axis=-1)
        m_c = jnp.split(silu_cc @ mod_w[layer] + mod_b[layer], N_MOD, axis=-1)
        f1 = (ffn1_w_gate[layer], ffn1_w_up[layer], ffn1_w_down[layer])
        f2 = (ffn2_w_gate[layer], ffn2_w_up[layer], ffn2_w_down[layer])

        xl = xl + 0.5 * m_l[2] * swiglu(modulated_norm(xl, norm_ffn1[layer], m_l[0], m_l[1]), *f1)
        xc = xc + 0.5 * m_c[2] * swiglu(modulated_norm(xc, norm_ffn1[layer], m_c[0], m_c[1]), *f1)

        hl = modulated_norm(xl, norm_mix[layer], m_l[3], m_l[4])
        hc = modulated_norm(xc, norm_mix[layer], m_c[3], m_c[4])
        i = layer // 2
        if layer % 2 == 0:
            mc, ml = conv_attn_mixer(hc, hl, hyb_w_in[i], hyb_conv_w[i], hyb_q_norm[i], hyb_k_norm[i],
                                     hyb_w_out[i], cos_a, sin_a, need_ctx)
        else:
            mc, ml = mla_mixer(hc, hl, mla_w_down[i], mla_q_norm[i], mla_kv_norm[i], mla_w_uq[i],
                               mla_w_ukv[i], mla_w_o[i], cos_m, sin_m, need_ctx)
        xl = xl + m_l[5] * ml

        xl = xl + 0.5 * m_l[8] * swiglu(modulated_norm(xl, norm_ffn2[layer], m_l[6], m_l[7]), *f2)
        if need_ctx:
            xc = xc + m_c[5] * mc
            xc = xc + 0.5 * m_c[8] * swiglu(modulated_norm(xc, norm_ffn2[layer], m_c[6], m_c[7]), *f2)
    return rms_norm(xl, final_norm)
```

```cpp
#include <hip/hip_runtime.h>
#include <cstdio>
#include <cstdint>
__device__ __forceinline__ int hw_lane() { return (int)__builtin_amdgcn_mbcnt_hi(~0u, __builtin_amdgcn_mbcnt_lo(~0u, 0u)); }
#define FRESH_LANE(l) int l = hw_lane(); asm volatile("" : "+v"(l))
#ifndef XH
#define XH 1
#endif
#if XH
typedef _Float16 xres_t;
#else
typedef float xres_t;
#endif
typedef _Float16 xh4_t __attribute__((ext_vector_type(4)));
typedef float xf4_t __attribute__((ext_vector_type(4)));
__device__ __forceinline__ xf4_t xres_ld4(const xres_t* p) {
#if XH
    return __builtin_convertvector(*(const xh4_t*)p, xf4_t);
#else
    return *(const xf4_t*)p;
#endif
}
__device__ __forceinline__ void xres_st4(xres_t* p, xf4_t v) {
#if XH
    *(xh4_t*)p = __builtin_convertvector(v, xh4_t);
#else
    *(xf4_t*)p = v;
#endif
}
typedef _Float16 xh8_t __attribute__((ext_vector_type(8)));
typedef float xf8_t __attribute__((ext_vector_type(8)));
__device__ __forceinline__ void xres_ld8(const xres_t* p, xf4_t& a, xf4_t& b) {
#if XH
    const xf8_t v = __builtin_convertvector(*(const xh8_t*)p, xf8_t); a = (xf4_t){v[0], v[1], v[2], v[3]}; b = (xf4_t){v[4], v[5], v[6], v[7]};
#else
    a = *(const xf4_t*)p; b = *(const xf4_t*)(p + 4);
#endif
}
__device__ __forceinline__ void xres_st8(xres_t* p, xf4_t a, xf4_t b) {
#if XH
    const xf8_t v = {a[0], a[1], a[2], a[3], b[0], b[1], b[2], b[3]}; *(xh8_t*)p = __builtin_convertvector(v, xh8_t);
#else
    *(xf4_t*)p = a; *(xf4_t*)(p + 4) = b;
#endif
}
#ifndef WT_X
#define WT_X 0
#endif
#ifndef WT_H
#define WT_H 0
#endif
#ifndef WT_O
#define WT_O 0
#endif
typedef unsigned wt_v4u __attribute__((ext_vector_type(4)));
__device__ __forceinline__ __amdgpu_buffer_rsrc_t wt_rsrc(const void* base, size_t bytes) { return __builtin_amdgcn_make_buffer_rsrc((void*)base, (short)0, (int)bytes, 0x00020000); }
template <int WT> __device__ __forceinline__ void wt_store16(__amdgpu_buffer_rsrc_t r, unsigned byte_off, wt_v4u v) { __builtin_amdgcn_raw_buffer_store_b128(v, r, (int)byte_off, 0, WT == 1 ? 16 : WT); }
#if XH
__device__ __forceinline__ void xres_st8_wt(__amdgpu_buffer_rsrc_t r, unsigned elem_off, xf4_t a, xf4_t b) {
    const xf8_t v = {a[0], a[1], a[2], a[3], b[0], b[1], b[2], b[3]}; const xh8_t h = __builtin_convertvector(v, xh8_t); wt_store16<WT_X>(r, elem_off * 2u, __builtin_bit_cast(wt_v4u, h)); }
#endif
#ifndef BATCH_LOCAL
#define BATCH_LOCAL 0
#endif
namespace pg8 {
#define PG8_LAS __attribute__((address_space(3)))
typedef unsigned short bf16_t;
typedef short bf16x8 __attribute__((ext_vector_type(8)));
typedef float f32x4 __attribute__((ext_vector_type(4)));
typedef unsigned u32x4 __attribute__((ext_vector_type(4)));
constexpr int BM = 256, BK = 64, HALF = 128, HTB = HALF * BK * 2  , STAGE_BYTES = 8 * HTB, NXCD = 8, WGM = 8;

__host__ __device__ __forceinline__ int lds_byte(int r, int c) { const int st = (r >> 4) * 2 + (c >> 5), rr = r & 15, cc = c & 31, ob = rr * 64 + cc * 2; return st * 1024 + (ob ^ (((ob >> 9) & 1) << 5)); }
__host__ __device__ __forceinline__ void stage_rc(int b, int& R, int& C) { const int st = b / 1024, sb = b % 1024, swz = sb ^ (((sb >> 9) & 1) << 5); R = (st >> 1) * 16 + swz / 64; C = (st & 1) * 32 + (swz % 64) / 2; }
__host__ __device__ __forceinline__ int perm32(int rho) { const int n = rho >> 4, i = rho & 15; return 8 * (i >> 2) + 4 * n + (i & 3); }

__host__ __device__ __forceinline__ size_t img_off(int row, int col, int K) { return ((size_t)(row >> 7) * (K >> 6) + (col >> 6)) * 16384 + lds_byte(row & 127, col & 63); }
__host__ __device__ __forceinline__ int img_row_perm(int n) { const int p = n & 31; return (n & ~31) + 16 * ((p >> 2) & 1) + 4 * (p >> 3) + (p & 3); }
__host__ __device__ __forceinline__ int img_row_perm_adj(int n) { const int g = (n >> 5) & 7; return (n & ~255) + 128 * (g & 1) + 32 * (g >> 1) + (img_row_perm(n) & 31); }
struct Unit { int pm, pn, k0, kq; };
struct Gemm { const bf16_t* A; const bf16_t* Bt; int lda, ldb, nt; };

#ifndef SCHED_FDIV
#define SCHED_FDIV 0
#endif
struct Sched {
    int nM, nN, nNr, nwg, G, c, mmode, kchunk, wgm, pm0, pn0, bl;
#ifdef PROBE_DOWN
    int probe_alias = 0;
#endif
    __device__ __forceinline__ void init(int nM_, int nNr_, int ksplit, int kchunk_, int mmode_, int G_, int c_, int wgm_ = WGM, int pm0_ = 0, int pn0_ = 0) { nM = nM_; nNr = nNr_; nN = nNr_ * ksplit; nwg = nM * nN; G = G_; c = c_; mmode = mmode_; kchunk = kchunk_; wgm = wgm_; pm0 = pm0_; pn0 = pn0_;
        bl = (BATCH_LOCAL && G_ == 256 && (nM_ & 7) == 0 && pm0_ == 0 && pn0_ == 0) ? 1 : 0;
    }
#if SCHED_FDIV
    static __device__ __forceinline__ int fdiv(int a, int b) { return (int)(((float)a + 0.5f) * __builtin_amdgcn_rcpf((float)b)); }
#endif
    __device__ __forceinline__ bool next(int i, Unit& u) const {
        if (bl) {
            const int x = c & 7, r = c >> 3, nMb = nM >> 3; const int L = i * (G >> 3) + r; if (L >= nMb * nN) return false;
            const int vn = L / nMb, vm = L - vn * nMb, kq = vn / nNr; u.pn = vn - kq * nNr; u.k0 = kq * kchunk; u.kq = kq;
            u.pm = 9 * x + (mmode == 0 ? vm : (mmode == 1 ? 1 + vm : 0)); return true; }
        const long L = (long)i * G + c; if (L >= nwg) return false;
        int wgid = (int)L; { const int q = nwg / NXCD, r = nwg % NXCD, xcd = wgid % NXCD, off = wgid / NXCD; wgid = (xcd < r ? xcd * (q + 1) : r * (q + 1) + (xcd - r) * q) + off; }
#if SCHED_FDIV
        const int nig = wgm * nN, gid = fdiv(wgid, nig), fm = gid * wgm, rem = wgid - gid * nig, gsz = (nM - fm) < wgm ? (nM - fm) : wgm;
        const int vn = fdiv(rem, gsz), vm = fm + rem - vn * gsz;
        const int kq = fdiv(vn, nNr); u.pn = pn0 + vn - kq * nNr; u.k0 = kq * kchunk; u.kq = kq;
#else
        const int nig = wgm * nN, gid = wgid / nig, fm = gid * wgm, gsz = (nM - fm) < wgm ? (nM - fm) : wgm;
        const int vm = fm + ((wgid % nig) % gsz), vn = (wgid % nig) / gsz;
        const int kq = vn / nNr; u.pn = pn0 + vn - kq * nNr; u.k0 = kq * kchunk; u.kq = kq;
#endif
        u.pm = (mmode == 0) ? pm0 + vm : ((mmode == 1) ? ((vm >> 3) * 9 + 1 + (vm & 7)) : vm * 9);
#ifdef PROBE_DOWN
        if (probe_alias) u.pm = 1 + (vm & 7);
#endif
        return true;
    }
};

__device__ __forceinline__ unsigned cvt_pk_bf16(float lo, float hi) { unsigned r; asm volatile("v_cvt_pk_bf16_f32 %0, %1, %2" : "=v"(r) : "v"(lo), "v"(hi)); return r; }
__device__ __forceinline__ float silu_f(float g) { return g * __builtin_amdgcn_rcpf(1.0f + __builtin_amdgcn_exp2f(-1.4426950408889634f * g)); }
#ifndef SWIGLU_PK
#define SWIGLU_PK 0
#endif
typedef float f32x2 __attribute__((ext_vector_type(2)));
__device__ __forceinline__ unsigned cvt_pk_bf16_nv(float lo, float hi) { unsigned r; asm("v_cvt_pk_bf16_f32 %0, %1, %2" : "=v"(r) : "v"(lo), "v"(hi)); return r; }
__device__ __forceinline__ unsigned swiglu_pk2(f32x2 g, f32x2 u) {
    const f32x2 c = g * (f32x2){-1.4426950408889634f, -1.4426950408889634f};
    f32x2 e; e.x = __builtin_amdgcn_exp2f(c.x); e.y = __builtin_amdgcn_exp2f(c.y);
    const f32x2 d = e + (f32x2){1.0f, 1.0f};
    f32x2 r; r.x = __builtin_amdgcn_rcpf(d.x); r.y = __builtin_amdgcn_rcpf(d.y);
    const f32x2 o = (g * u) * r;
    return cvt_pk_bf16_nv(o.x, o.y);
}

struct EpiStore {
    static constexpr int ZKIND = 1; static constexpr bool PERM = true, TWICE = false;
    bf16_t* O; int ldc;
    __device__ __forceinline__ void operator()(const f32x4 (&acc)[2][2][4][2], const Unit& u, int wr, int wc, int fr, int fq) const {
        const int row0 = u.pm * BM + wr * 64 + fr, col0 = u.pn * BM + wc * 32 + 8 * fq;
        const __amdgpu_buffer_rsrc_t rs = wt_rsrc(O, (size_t)18432 * ldc * 2);
#pragma unroll
        for (int ai = 0; ai < 2; ++ai)
#pragma unroll
            for (int m = 0; m < 4; ++m) { const unsigned ro = (unsigned)((row0 + ai * HALF + m * 16) * ldc + col0) * 2u;
#pragma unroll
                for (int bj = 0; bj < 2; ++bj) { const f32x4 v0 = acc[ai][bj][m][0], v1 = acc[ai][bj][m][1];
                    u32x4 w; w.x = cvt_pk_bf16(v0[0], v0[1]); w.y = cvt_pk_bf16(v0[2], v0[3]); w.z = cvt_pk_bf16(v1[0], v1[1]); w.w = cvt_pk_bf16(v1[2], v1[3]);
                    wt_store16<WT_O>(rs, ro + bj * HALF * 2, w); } }
    }
};
struct EpiStoreImg {
    static constexpr int ZKIND = 1; static constexpr bool PERM = true, TWICE = false;
    bf16_t* O; int ldc;
    __device__ __forceinline__ void operator()(const f32x4 (&acc)[2][2][4][2], const Unit& u, int wr, int wc, int fr, int fq) const {
        const int row0 = u.pm * BM + wr * 64 + fr, col0 = u.pn * BM + wc * 32 + 8 * fq;
        const __amdgpu_buffer_rsrc_t rs = wt_rsrc(O, (size_t)18432 * ldc * 2);
#pragma unroll
        for (int ai = 0; ai < 2; ++ai)
#pragma unroll
            for (int m = 0; m < 4; ++m) {
#pragma unroll
                for (int bj = 0; bj < 2; ++bj) { const f32x4 v0 = acc[ai][bj][m][0], v1 = acc[ai][bj][m][1];
                    u32x4 w; w.x = cvt_pk_bf16(v0[0], v0[1]); w.y = cvt_pk_bf16(v0[2], v0[3]); w.z = cvt_pk_bf16(v1[0], v1[1]); w.w = cvt_pk_bf16(v1[2], v1[3]);
                    wt_store16<0>(rs, (unsigned)img_off(row0 + ai * HALF + m * 16, col0 + bj * HALF, ldc), w); } }
    }
};
#if defined(PROBE_DOWN) || defined(PROBE_GU)
struct EpiStoreSwap {
    static constexpr int ZKIND = 0; static constexpr bool PERM = true, TWICE = false;
    bf16_t* O; int ldc;
    __device__ __forceinline__ void operator()(const f32x4 (&acc)[2][2][4][2], const Unit& u, int wr, int wc, int fr, int fq) const {
        const bool lo = fr < 8;
        const int row0 = u.pm * BM + wr * 64 + (fr & 7), col0 = u.pn * BM + wc * 64 + (lo ? 0 : 32) + 8 * fq;
        const __amdgpu_buffer_rsrc_t rs = wt_rsrc(O, (size_t)18432 * ldc * 2);
#pragma unroll
        for (int ai = 0; ai < 2; ++ai)
#pragma unroll
            for (int m = 0; m < 4; ++m) { const unsigned ro = (unsigned)((row0 + ai * HALF + m * 16) * ldc + col0) * 2u;
                u32x4 w[2];
#pragma unroll
                for (int bj = 0; bj < 2; ++bj) { const f32x4 v0 = acc[ai][bj][m][0], v1 = acc[ai][bj][m][1];
                    w[bj].x = cvt_pk_bf16(v0[0], v0[1]); w[bj].y = cvt_pk_bf16(v0[2], v0[3]); w[bj].z = cvt_pk_bf16(v1[0], v1[1]); w[bj].w = cvt_pk_bf16(v1[2], v1[3]); }
                u32x4 snd, rcv;
#pragma unroll
                for (int e = 0; e < 4; ++e) { snd[e] = lo ? w[1][e] : w[0][e]; rcv[e] = (unsigned)__builtin_amdgcn_update_dpp(0, (int)snd[e], 0x128, 0xf, 0xf, false); }
                u32x4 dA, dB;
#pragma unroll
                for (int e = 0; e < 4; ++e) { dA[e] = lo ? w[0][e] : rcv[e]; dB[e] = lo ? rcv[e] : w[1][e]; }
                wt_store16<0>(rs, ro, dA); wt_store16<0>(rs, ro + (unsigned)(8 * ldc) * 2u, dB); }
    }
};
struct EpiNull {
    static constexpr int ZKIND = 0; static constexpr bool PERM = true, TWICE = false;
    __device__ __forceinline__ void operator()(const f32x4 (&acc)[2][2][4][2], const Unit& u, int wr, int wc, int fr, int fq) const {
#pragma unroll
        for (int ai = 0; ai < 2; ++ai)
#pragma unroll
            for (int bj = 0; bj < 2; ++bj)
#pragma unroll
                for (int m = 0; m < 4; ++m)
#pragma unroll
                    for (int n = 0; n < 2; ++n) asm volatile("" :: "v"(acc[ai][bj][m][n]));
    }
};
#endif
#ifndef SWIGLU_UOFF
#define SWIGLU_UOFF 0
#endif
template <bool IMG> struct EpiSwiGLU {
    static constexpr int ZKIND = 0; static constexpr bool PERM = true, TWICE = true;
    bf16_t* O; int ldc;
    __device__ __forceinline__ void operator()(const f32x4 (&acc)[2][2][4][2], const Unit& u, int wr, int wc, int fr, int fq) const {
        const int row0 = u.pm * BM + wr * 64 + fr, col0 = u.pn * HALF + wc * 32 + 8 * fq;
        const __amdgpu_buffer_rsrc_t rs = wt_rsrc(O, (size_t)18432 * ldc * 2);
        const unsigned loff = (unsigned)((fr * 64 + fq * 16) ^ ((fr >> 3) << 5));
        const unsigned ub = (unsigned)((u.pm * 2) * (ldc >> 6) + u.pn * 2 + (wc >> 1)) * 16384u + (unsigned)((wr * 4) * 2 + (wc & 1)) * 1024u, ua = (unsigned)(ldc >> 6) * 16384u;
#pragma unroll
        for (int ai = 0; ai < 2; ++ai)
#pragma unroll
            for (int m = 0; m < 4; ++m) { const unsigned ro = IMG ? (SWIGLU_UOFF ? ub + (unsigned)ai * ua + (unsigned)m * 2048u + loff : (unsigned)img_off(row0 + ai * HALF + m * 16, col0, ldc)) : (unsigned)((row0 + ai * HALF + m * 16) * ldc + col0) * 2u;
                const f32x4 g0 = acc[ai][0][m][0], g1 = acc[ai][0][m][1], u0 = acc[ai][1][m][0], u1 = acc[ai][1][m][1];
                u32x4 w;
#if SWIGLU_PK
                w.x = swiglu_pk2((f32x2){g0[0], g0[1]}, (f32x2){u0[0], u0[1]}); w.y = swiglu_pk2((f32x2){g0[2], g0[3]}, (f32x2){u0[2], u0[3]});
                w.z = swiglu_pk2((f32x2){g1[0], g1[1]}, (f32x2){u1[0], u1[1]}); w.w = swiglu_pk2((f32x2){g1[2], g1[3]}, (f32x2){u1[2], u1[3]});
#else
                w.x = cvt_pk_bf16(silu_f(g0[0]) * u0[0], silu_f(g0[1]) * u0[1]); w.y = cvt_pk_bf16(silu_f(g0[2]) * u0[2], silu_f(g0[3]) * u0[3]);
                w.z = cvt_pk_bf16(silu_f(g1[0]) * u1[0], silu_f(g1[1]) * u1[1]); w.w = cvt_pk_bf16(silu_f(g1[2]) * u1[2], silu_f(g1[3]) * u1[3]);
#endif
                wt_store16<WT_H>(rs, ro, w); }
    }
};
#ifndef RES_PERM
#define RES_PERM 2
#endif
#ifndef RMW_PIPE
#define RMW_PIPE 0
#endif
#ifndef XT
#define XT 0
#endif
#if XT
static_assert(XH && RES_PERM == 2, "the image-layout residual stream needs fp16 storage and the adjacent-halves permutation");
template <bool HALFC  , bool PART> struct EpiResid {
    static constexpr int ZKIND = 2; static constexpr bool PERM = true, TWICE = false;
    xres_t* X; const float* gate; float* P; const float* xin; const float* cin; xres_t* xout;
    __device__ __forceinline__ void operator()(const f32x4 (&acc)[2][2][4][2], const Unit& u, int wr, int wc, int fr, int fq) const {
        const int col0 = u.pn * BM + wc * 64 + 8 * fq;
        const int bq = u.pm / 9, r = (u.pm - bq * 9 == 0) ? 8 : bq;
        const float* gv = gate + (size_t)r * 18432 + col0;
        f32x4 gg[2][2];
#pragma unroll
        for (int bj = 0; bj < 2; ++bj)
#pragma unroll
            for (int n = 0; n < 2; ++n) gg[bj][n] = *(const f32x4*)(gv + bj * 32 + n * 4) * (HALFC ? 0.5f : 1.0f);
        const unsigned loff = (unsigned)((fr * 64 + fq * 16) ^ ((fr >> 3) << 5));
        if constexpr (PART) {
            const __amdgpu_buffer_rsrc_t rs = wt_rsrc(P, (size_t)4 * 2048 * 2048 * 2);
            const unsigned ub = (unsigned)u.kq * (2048u * 4096u) + (unsigned)((bq * 2) * 32 + u.pn * 4 + wc) * 16384u + (unsigned)(wr * 4 * 2) * 1024u;
#pragma unroll
            for (int ai = 0; ai < 2; ++ai)
#pragma unroll
                for (int m = 0; m < 4; ++m)
#pragma unroll
                    for (int bj = 0; bj < 2; ++bj) { const f32x4 a = acc[ai][bj][m][0] * gg[bj][0], b = acc[ai][bj][m][1] * gg[bj][1];
                        const xf8_t v = {a[0], a[1], a[2], a[3], b[0], b[1], b[2], b[3]}; const xh8_t h = __builtin_convertvector(v, xh8_t);
#ifdef XT_PTR
                        *(wt_v4u*)((char*)P + (size_t)(ub + (unsigned)(ai * 32) * 16384u + (unsigned)(m * 2 + bj) * 1024u) + loff) = __builtin_bit_cast(wt_v4u, h); }
#else
                        __builtin_amdgcn_raw_buffer_store_b128(__builtin_bit_cast(wt_v4u, h), rs, (int)loff, (int)(ub + (unsigned)(ai * 32) * 16384u + (unsigned)(m * 2 + bj) * 1024u), 0); }
#endif
        } else {
            const int tin = u.pm - bq * 9;
            const float* src = xin ? (tin == 0 ? cin + (size_t)(bq * 256 + wr * 64 + fr) * 2048 : xin + (size_t)(bq * 2048 + (tin - 1) * 256 + wr * 64 + fr) * 2048) + col0 : nullptr;
            const __amdgpu_buffer_rsrc_t rsx = wt_rsrc(X, (size_t)18432 * 2048 * 2);
            const __amdgpu_buffer_rsrc_t rso = wt_rsrc(xout ? xout : X, (size_t)18432 * 2048 * 2);
            const unsigned ub = (unsigned)((u.pm * 2) * 32 + u.pn * 4 + wc) * 16384u + (unsigned)(wr * 4 * 2) * 1024u;
            const unsigned urm = (unsigned)((u.pm * BM + wr * 64) * 2048 + u.pn * BM + wc * 64) * 2u, lrm = (unsigned)(fr * 2048 + 8 * fq) * 2u;
            const unsigned lst = xout ? lrm : loff;
#pragma unroll
            for (int ai = 0; ai < 2; ++ai)
#pragma unroll
                for (int m = 0; m < 4; ++m) {
                    f32x4 xv[2][2];
                    if (src) { const float* srcp = src + (size_t)(ai * HALF + m * 16) * 2048;
#pragma unroll
                        for (int bj = 0; bj < 2; ++bj)
#pragma unroll
                            for (int n = 0; n < 2; ++n) xv[bj][n] = *(const f32x4*)(srcp + bj * 32 + n * 4);
                    } else {
#pragma unroll
                        for (int bj = 0; bj < 2; ++bj) {
#ifdef XT_PTR
                            const wt_v4u raw = *(const wt_v4u*)((const char*)X + (size_t)(ub + (unsigned)(ai * 32) * 16384u + (unsigned)(m * 2 + bj) * 1024u) + loff);
#else
                            const wt_v4u raw = __builtin_amdgcn_raw_buffer_load_b128(rsx, (int)loff, (int)(ub + (unsigned)(ai * 32) * 16384u + (unsigned)(m * 2 + bj) * 1024u), 0);
#endif
                            const xf8_t t = __builtin_convertvector(__builtin_bit_cast(xh8_t, raw), xf8_t); xv[bj][0] = (f32x4){t[0], t[1], t[2], t[3]}; xv[bj][1] = (f32x4){t[4], t[5], t[6], t[7]}; }
                    }
#pragma unroll
                    for (int bj = 0; bj < 2; ++bj) { const f32x4 a = xv[bj][0] + acc[ai][bj][m][0] * gg[bj][0], b = xv[bj][1] + acc[ai][bj][m][1] * gg[bj][1];
                        const xf8_t v = {a[0], a[1], a[2], a[3], b[0], b[1], b[2], b[3]}; const xh8_t h = __builtin_convertvector(v, xh8_t);
                        const unsigned so = xout ? urm + (unsigned)((ai * HALF + m * 16) * 2048 + bj * 32) * 2u : ub + (unsigned)(ai * 32) * 16384u + (unsigned)(m * 2 + bj) * 1024u;
#ifdef XT_PTR
                        *(wt_v4u*)((char*)(xout ? xout : X) + (size_t)so + lst) = __builtin_bit_cast(wt_v4u, h); }
#else
                        __builtin_amdgcn_raw_buffer_store_b128(__builtin_bit_cast(wt_v4u, h), rso, (int)lst, (int)so, 0); }
#endif
                    if (m & 1) asm volatile("" ::: "memory"); }
        }
    }
};
#else
template <bool HALFC  , bool PART> struct EpiResid {
    static constexpr int ZKIND = 2; static constexpr bool PERM = RES_PERM != 0, TWICE = false;
    xres_t* X; const float* gate; float* P; const float* xin; const float* cin; xres_t* xout  ;
    __device__ __forceinline__ void operator()(const f32x4 (&acc)[2][2][4][2], const Unit& u, int wr, int wc, int fr, int fq) const {
        constexpr int NS = PERM ? 4 : 16;
        constexpr int BJS = RES_PERM == 2 ? 32 : HALF;
        const int col0 = u.pn * BM + wc * (RES_PERM == 2 ? 64 : 32) + (PERM ? 8 : 4) * fq;
        const int bq = u.pm / 9, r = (u.pm - bq * 9 == 0) ? 8 : bq;
        const float* gv = gate + (size_t)r * 18432 + col0;
        f32x4 gg[2][2];
#pragma unroll
        for (int bj = 0; bj < 2; ++bj)
#pragma unroll
            for (int n = 0; n < 2; ++n) gg[bj][n] = *(const f32x4*)(gv + bj * BJS + n * NS) * (HALFC ? 0.5f : 1.0f);
        if constexpr (PART) {
            xres_t* base = (xres_t*)P + ((size_t)u.kq * 2048 + (size_t)(bq * BM + wr * 64 + fr)) * 2048 + col0;
#if XH
            const __amdgpu_buffer_rsrc_t rs = wt_rsrc(P, (size_t)4 * 2048 * 2048 * 2);
#endif
#pragma unroll
            for (int ai = 0; ai < 2; ++ai)
#pragma unroll
                for (int m = 0; m < 4; ++m) { xres_t* rowp = base + (size_t)(ai * HALF + m * 16) * 2048;
#pragma unroll
                    for (int bj = 0; bj < 2; ++bj) {
#if XH
                        if constexpr (PERM) xres_st8_wt(rs, (unsigned)(rowp + bj * BJS - (xres_t*)P), acc[ai][bj][m][0] * gg[bj][0], acc[ai][bj][m][1] * gg[bj][1]);
#else
                        if constexpr (PERM) xres_st8(rowp + bj * BJS, acc[ai][bj][m][0] * gg[bj][0], acc[ai][bj][m][1] * gg[bj][1]);
#endif
                        else { xres_st4(rowp + bj * BJS, acc[ai][bj][m][0] * gg[bj][0]); xres_st4(rowp + bj * BJS + 16, acc[ai][bj][m][1] * gg[bj][1]); } } }
        } else {
            const int row0 = u.pm * BM + wr * 64 + fr;
#if XH
            const __amdgpu_buffer_rsrc_t rsx = wt_rsrc(X, (size_t)18432 * 2048 * 2);
#endif
            const int tin = u.pm - bq * 9;
            const float* src = xin ? (tin == 0 ? cin + (size_t)(bq * 256 + wr * 64 + fr) * 2048 : xin + (size_t)(bq * 2048 + (tin - 1) * 256 + wr * 64 + fr) * 2048) + col0 : nullptr;
#if XH && RMW_PIPE
            if constexpr (PERM) if (!src) {
                xh8_t raw[2][2][2];
                xres_t* const xb = X + (size_t)row0 * 2048 + col0;
#define RP_LOAD(slot_, p_) do { _Pragma("unroll") for (int g_ = 0; g_ < 2; ++g_) _Pragma("unroll") for (int bj = 0; bj < 2; ++bj) \
                    raw[slot_][g_][bj] = *(const xh8_t*)(xb + (size_t)((((p_) * 2 + g_) >> 2) * HALF + (((p_) * 2 + g_) & 3) * 16) * 2048 + bj * BJS); } while (0)
                RP_LOAD(0, 0);
#pragma unroll
                for (int p = 0; p < 4; ++p) {
                    if (p < 3) { if (p & 1) RP_LOAD(0, p + 1); else RP_LOAD(1, p + 1); }
                    asm volatile("" ::: "memory");
#pragma unroll
                    for (int g_ = 0; g_ < 2; ++g_) { const int ai = (p * 2 + g_) >> 2, m = (p * 2 + g_) & 3; xres_t* rowp = xb + (size_t)(ai * HALF + m * 16) * 2048;
#pragma unroll
                        for (int bj = 0; bj < 2; ++bj) { const xf8_t t = __builtin_convertvector(raw[p & 1][g_][bj], xf8_t);
                            const f32x4 x0 = (f32x4){t[0], t[1], t[2], t[3]}, x1 = (f32x4){t[4], t[5], t[6], t[7]};
                            xres_st8_wt(rsx, (unsigned)(rowp + bj * BJS - X), x0 + acc[ai][bj][m][0] * gg[bj][0], x1 + acc[ai][bj][m][1] * gg[bj][1]); } }
                    asm volatile("" ::: "memory");
                }
#undef RP_LOAD
                return;
            }
#endif
#pragma unroll
            for (int ai = 0; ai < 2; ++ai)
#pragma unroll
                for (int m = 0; m < 4; ++m) { xres_t* rowp = X + (size_t)(row0 + ai * HALF + m * 16) * 2048 + col0;
                    f32x4 xv[2][2];
                    if (src) { const float* srcp = src + (size_t)(ai * HALF + m * 16) * 2048;
#pragma unroll
                        for (int bj = 0; bj < 2; ++bj)
#pragma unroll
                            for (int n = 0; n < 2; ++n) xv[bj][n] = *(const f32x4*)(srcp + bj * BJS + n * NS);
                    } else {
#pragma unroll
                        for (int bj = 0; bj < 2; ++bj) {
                            if constexpr (PERM) xres_ld8(rowp + bj * BJS, xv[bj][0], xv[bj][1]);
                            else { xv[bj][0] = xres_ld4(rowp + bj * BJS); xv[bj][1] = xres_ld4(rowp + bj * BJS + 16); } }
                    }
#pragma unroll
                    for (int bj = 0; bj < 2; ++bj) {
#if XH
                        if constexpr (PERM) xres_st8_wt(rsx, (unsigned)(rowp + bj * BJS - X), xv[bj][0] + acc[ai][bj][m][0] * gg[bj][0], xv[bj][1] + acc[ai][bj][m][1] * gg[bj][1]);
#else
                        if constexpr (PERM) xres_st8(rowp + bj * BJS, xv[bj][0] + acc[ai][bj][m][0] * gg[bj][0], xv[bj][1] + acc[ai][bj][m][1] * gg[bj][1]);
#endif
                        else { xres_st4(rowp + bj * BJS, xv[bj][0] + acc[ai][bj][m][0] * gg[bj][0]); xres_st4(rowp + bj * BJS + 16, xv[bj][1] + acc[ai][bj][m][1] * gg[bj][1]); } }
                    if (m & 1) asm volatile("" ::: "memory"); }
        }
    }
};

#endif

template <class Epi, bool IMGA = false, bool IMGB = false, bool KREV = false>
__device__ __forceinline__ void gemm_phase(PG8_LAS unsigned char* lds, const Gemm g, const Sched& S, const Epi& E, const int wid  ) {
    FRESH_LANE(lane);
    const int tid = wid * 64 + lane, wr = wid >> 2, wc = wid & 3, fr = lane & 15, fq = lane >> 4;
    const int nt = g.nt;
    unsigned voffA[2], voffB[2];
#pragma unroll
    for (int i = 0; i < 2; ++i) { int R, C; stage_rc(tid * 16 + i * 8192, R, C); const int Rb = Epi::PERM ? ((R & ~31) + perm32(R & 31)) : R;
        voffA[i] = IMGA ? (unsigned)(tid * 16 + i * 8192) : (unsigned)(R * g.lda + C) * 2u; voffB[i] = IMGB ? (unsigned)(tid * 16 + i * 8192) : (unsigned)(Rb * g.ldb + C) * 2u; }
    const size_t kabsA = IMGA ? (size_t)HTB : (size_t)(BK * 2), kabsB = IMGB ? (size_t)HTB : (size_t)(BK * 2);
    const size_t kstepA = KREV ? (size_t)0 - kabsA : kabsA, kstepB = KREV ? (size_t)0 - kabsB : kabsB;
#define PG8_K0A(k0) ((IMGA ? (size_t)((k0) >> 6) * HTB : (size_t)(k0) * 2) + (KREV ? (size_t)(nt - 1) * kabsA : (size_t)0))
#define PG8_K0B(k0) ((IMGB ? (size_t)((k0) >> 6) * HTB : (size_t)(k0) * 2) + (KREV ? (size_t)(nt - 1) * kabsB : (size_t)0))
    const size_t hstepA = (size_t)HALF * g.lda * 2, hstepB = (size_t)HALF * g.ldb * 2;
    const size_t tstepA = 2 * hstepA, tstepB = 2 * hstepB;
    const unsigned ldsw = (unsigned)wid * 1024u;
    const int aoff = lds_byte(wr * 64 + fr, fq * 8), boff = lds_byte(wc * 32 + fr, fq * 8);
#define PG8_SA(b, h) (((b) * 2 + (h)) * HTB)
#define PG8_SB(b, h) ((4 + (b) * 2 + (h)) * HTB)
#ifndef ALIGN_EPI
#define ALIGN_EPI 1
#endif
#ifndef PG8_AUX_A
#define PG8_AUX_A 0
#endif
#ifndef PG8_AUX_B
#define PG8_AUX_B 0
#endif
#define PG8_STAGE(bufoff, gbase, voff) do { _Pragma("unroll") for (int _i = 0; _i < 2; ++_i) { \
        if ((bufoff) < 4 * HTB) __builtin_amdgcn_global_load_lds((const unsigned*)((const char*)(gbase) + (voff)[_i]), (PG8_LAS unsigned*)(lds + (bufoff) + ldsw + _i * 8192), 16, 0, PG8_AUX_A); \
        else __builtin_amdgcn_global_load_lds((const unsigned*)((const char*)(gbase) + (voff)[_i]), (PG8_LAS unsigned*)(lds + (bufoff) + ldsw + _i * 8192), 16, 0, PG8_AUX_B); } } while (0)
#define PG8_LDA(dst, b, h) do { _Pragma("unroll") for (int m = 0; m < 4; ++m) _Pragma("unroll") for (int k = 0; k < 2; ++k) dst[m][k] = *(const PG8_LAS bf16x8*)(lds + PG8_SA(b, h) + aoff + m * 2048 + k * 1024); } while (0)
#define PG8_LDB(dst, b, h) do { _Pragma("unroll") for (int n = 0; n < 2; ++n) _Pragma("unroll") for (int k = 0; k < 2; ++k) dst[n][k] = *(const PG8_LAS bf16x8*)(lds + PG8_SB(b, h) + boff + n * 2048 + k * 1024); } while (0)
#define PG8_MMA(ai, bj, At, Bt) do { __builtin_amdgcn_s_setprio(1); _Pragma("unroll") for (int m = 0; m < 4; ++m) _Pragma("unroll") for (int n = 0; n < 2; ++n) _Pragma("unroll") for (int k = 0; k < 2; ++k) \
        acc[ai][bj][m][n] = __builtin_amdgcn_mfma_f32_16x16x32_bf16(Bt[n][k], At[m][k], acc[ai][bj][m][n], 0, 0, 0); __builtin_amdgcn_s_setprio(0); } while (0)
#define PG8_MMA0(ai, bj, At, Bt) do { __builtin_amdgcn_s_setprio(1); _Pragma("unroll") for (int m = 0; m < 4; ++m) _Pragma("unroll") for (int n = 0; n < 2; ++n) { \
        acc[ai][bj][m][n] = __builtin_amdgcn_mfma_f32_16x16x32_bf16(Bt[n][0], At[m][0], (f32x4){0.f, 0.f, 0.f, 0.f}, 0, 0, 0); \
        acc[ai][bj][m][n] = __builtin_amdgcn_mfma_f32_16x16x32_bf16(Bt[n][1], At[m][1], acc[ai][bj][m][n], 0, 0, 0); } __builtin_amdgcn_s_setprio(0); } while (0)
#ifndef ACC_ZERO_MFMA
#define ACC_ZERO_MFMA 1
#endif
#ifndef ACC_ZERO_WHICH
#define ACC_ZERO_WHICH 1
#endif
#ifndef EARLY_FRAG
#define EARLY_FRAG 0
#endif
#ifndef LATE_NEXT_BR
#define LATE_NEXT_BR 1
#endif
#ifndef ACC_PEEL_WHICH
#define ACC_PEEL_WHICH 0
#endif
#define ACC_PEEL_SEL(E_) ((ACC_PEEL_WHICH & 2) && E_::ZKIND == 1 || (ACC_PEEL_WHICH & 4) && E_::ZKIND == 2)
#define ACC_ZERO_SEL(E_) ((ACC_ZERO_WHICH & 1) && E_::TWICE || (ACC_ZERO_WHICH & 2) && E_::ZKIND == 1 || (ACC_ZERO_WHICH & 4) && E_::ZKIND == 2)
#if ACC_ZERO_MFMA
#define PG8_MMAF(first, ai, bj, At, Bt) do { if (first) PG8_MMA0(ai, bj, At, Bt); else PG8_MMA(ai, bj, At, Bt); } while (0)
#else
#define PG8_MMAF(first, ai, bj, At, Bt) PG8_MMA(ai, bj, At, Bt)
#endif
#define PG8_WAIT_V(n) asm volatile("s_waitcnt vmcnt(" #n ")" ::: "memory")
#define PG8_WAIT_L(n) asm volatile("s_waitcnt lgkmcnt(" #n ")" ::: "memory")
#define PG8_BAR __builtin_amdgcn_s_barrier()
#define PG8_SCHED __builtin_amdgcn_sched_barrier(0)
#ifndef PG8_SP2
#define PG8_SP2 1
#endif
#if PG8_SP2
#define PG8_ITER(MM) PG8_ITERX(MM, 0)
#define PG8_ITERX(MM, SKIPLD) do { const bool last = (t == nt - 2); \
        const char* a1 = cA + (size_t)(t + 1) * kstepA; \
        const char* a2 = last ? nA : cA + (size_t)(t + 2) * kstepA; const char* b2 = last ? nB : cB + (size_t)(t + 2) * kstepB; \
        const char* a3 = a2 + kstepA; const char* b3 = b2 + kstepB; \
        if (!((SKIPLD) & 1)) { PG8_LDB(B0, 0, 0); PG8_LDB(B1, 0, 1); PG8_SCHED; } if (!((SKIPLD) & 2)) { PG8_LDA(At, 0, 0); } PG8_STAGE(PG8_SA(1, 1), a1 + hstepA, voffA); \
        PG8_WAIT_V(8); PG8_WAIT_L(0); PG8_BAR; MM(0, 0, At, B0); MM(0, 1, At, B1); PG8_BAR; PG8_SCHED; \
        PG8_LDA(At, 0, 1); PG8_STAGE(PG8_SB(0, 0), b2, voffB); PG8_STAGE(PG8_SB(0, 1), b2 + hstepB, voffB); PG8_STAGE(PG8_SA(0, 0), a2, voffA); \
        PG8_WAIT_V(8); PG8_WAIT_L(0); PG8_BAR; MM(1, 0, At, B0); MM(1, 1, At, B1); PG8_BAR; PG8_SCHED; \
        PG8_LDB(B0, 1, 0); PG8_LDB(B1, 1, 1); PG8_SCHED; PG8_LDA(At, 1, 0); PG8_STAGE(PG8_SA(0, 1), a2 + hstepA, voffA); \
        PG8_WAIT_V(8); PG8_WAIT_L(0); PG8_BAR; PG8_MMA(0, 0, At, B0); PG8_MMA(0, 1, At, B1); PG8_BAR; PG8_SCHED; \
        PG8_LDA(At, 1, 1); PG8_STAGE(PG8_SB(1, 0), b3, voffB); PG8_STAGE(PG8_SB(1, 1), b3 + hstepB, voffB); PG8_STAGE(PG8_SA(1, 0), a3, voffA); \
        PG8_WAIT_V(8); PG8_WAIT_L(0); PG8_BAR; PG8_MMA(1, 0, At, B0); PG8_MMA(1, 1, At, B1); PG8_BAR; PG8_SCHED; } while (0)
#endif
    Unit cur, nxt; int ui = 0;
    if (!S.next(0, cur)) return;
    f32x4 acc[2][2][4][2];
#pragma unroll
    for (int a = 0; a < 2; ++a)
#pragma unroll
        for (int b = 0; b < 2; ++b)
#pragma unroll
            for (int m = 0; m < 4; ++m)
#pragma unroll
                for (int n = 0; n < 2; ++n) acc[a][b][m][n] = (f32x4){0.f, 0.f, 0.f, 0.f};
    bf16x8 At[4][2], B0[2][2], B1[2][2];
    const char* cA = (const char*)g.A + (size_t)cur.pm * tstepA + PG8_K0A(cur.k0); const char* cB = (const char*)g.Bt + (size_t)cur.pn * tstepB + PG8_K0B(cur.k0);
#ifndef PG8_SP2
#define PG8_SP2 1
#endif
#if PG8_SP2
    PG8_STAGE(PG8_SB(0, 0), cB, voffB); PG8_STAGE(PG8_SB(0, 1), cB + hstepB, voffB); PG8_STAGE(PG8_SA(0, 0), cA, voffA); PG8_STAGE(PG8_SA(0, 1), cA + hstepA, voffA);
    if (wr == 1) PG8_BAR;
    PG8_WAIT_V(2); PG8_BAR;
    PG8_STAGE(PG8_SB(1, 0), cB + kstepB, voffB); PG8_STAGE(PG8_SA(1, 0), cA + kstepA, voffA); PG8_STAGE(PG8_SB(1, 1), cB + hstepB + kstepB, voffB);
    PG8_WAIT_V(6); PG8_BAR;
#else
    PG8_STAGE(PG8_SB(0, 0), cB, voffB); PG8_STAGE(PG8_SA(0, 0), cA, voffA); PG8_STAGE(PG8_SB(0, 1), cB + hstepB, voffB); PG8_STAGE(PG8_SA(0, 1), cA + hstepA, voffA);
    if (wr == 1) PG8_BAR;
    PG8_WAIT_V(4); PG8_BAR;
    PG8_STAGE(PG8_SB(1, 0), cB + kstepB, voffB); PG8_STAGE(PG8_SA(1, 0), cA + kstepA, voffA); PG8_STAGE(PG8_SB(1, 1), cB + hstepB + kstepB, voffB);
    PG8_WAIT_V(6); PG8_BAR;
#endif
#if PG8_SP2 && ACC_ZERO_MFMA && EARLY_FRAG
    if constexpr (ACC_ZERO_SEL(Epi)) { if (EARLY_FRAG & 1) { PG8_LDB(B0, 0, 0); PG8_LDB(B1, 0, 1); PG8_SCHED; } if (EARLY_FRAG & 2) { PG8_LDA(At, 0, 0); } }
#endif
    for (;;) {
#define PG8_NEXT() has_next = S.next(ui + 1, nxt); \
        nA = has_next ? (const char*)g.A + (size_t)nxt.pm * tstepA + PG8_K0A(nxt.k0) : cA; nB = has_next ? (const char*)g.Bt + (size_t)nxt.pn * tstepB + PG8_K0B(nxt.k0) : cB
        bool has_next; const char* nA = cA; const char* nB = cB;
#if PG8_SP2 && ACC_ZERO_MFMA
        if constexpr (ACC_ZERO_SEL(Epi)) {
            { const int t = 0; PG8_ITERX(PG8_MMA0, EARLY_FRAG); }
            PG8_NEXT();
            for (int t = 2; t < nt; t += 2) PG8_ITER(PG8_MMA);
        } else if constexpr (ACC_PEEL_SEL(Epi)) {
            { const int t = 0; PG8_ITER(PG8_MMA); }
            PG8_NEXT();
            for (int t = 2; t < nt; t += 2) PG8_ITER(PG8_MMA);
        } else if constexpr (LATE_NEXT_BR) { for (int t = 0; t < nt; t += 2) { if (t == 2) { PG8_NEXT(); } PG8_ITER(PG8_MMA); } }
        else { PG8_NEXT(); for (int t = 0; t < nt; t += 2) PG8_ITER(PG8_MMA); }
#elif PG8_SP2
        PG8_NEXT(); for (int t = 0; t < nt; t += 2) PG8_ITER(PG8_MMA);
#else
        PG8_NEXT();
        for (int t = 0; t < nt; t += 2) {
            const bool last = (t == nt - 2);
            const char* a1 = cA + (size_t)(t + 1) * kstepA;
            const char* a2 = last ? nA : cA + (size_t)(t + 2) * kstepA; const char* b2 = last ? nB : cB + (size_t)(t + 2) * kstepB;
            const char* a3 = a2 + kstepA; const char* b3 = b2 + kstepB;
#if PG8_SP2
            PG8_LDB(B0, 0, 0); PG8_LDB(B1, 0, 1); PG8_SCHED; PG8_LDA(At, 0, 0); PG8_STAGE(PG8_SA(1, 1), a1 + hstepA, voffA);
            PG8_WAIT_V(8); PG8_WAIT_L(0); PG8_BAR; PG8_MMAF(t == 0, 0, 0, At, B0); PG8_MMAF(t == 0, 0, 1, At, B1); PG8_BAR; PG8_SCHED;
            PG8_LDA(At, 0, 1); PG8_STAGE(PG8_SB(0, 0), b2, voffB); PG8_STAGE(PG8_SB(0, 1), b2 + hstepB, voffB); PG8_STAGE(PG8_SA(0, 0), a2, voffA);
            PG8_WAIT_V(8); PG8_WAIT_L(0); PG8_BAR; PG8_MMAF(t == 0, 1, 0, At, B0); PG8_MMAF(t == 0, 1, 1, At, B1); PG8_BAR; PG8_SCHED;
            PG8_LDB(B0, 1, 0); PG8_LDB(B1, 1, 1); PG8_SCHED; PG8_LDA(At, 1, 0); PG8_STAGE(PG8_SA(0, 1), a2 + hstepA, voffA);
            PG8_WAIT_V(8); PG8_WAIT_L(0); PG8_BAR; PG8_MMA(0, 0, At, B0); PG8_MMA(0, 1, At, B1); PG8_BAR; PG8_SCHED;
            PG8_LDA(At, 1, 1); PG8_STAGE(PG8_SB(1, 0), b3, voffB); PG8_STAGE(PG8_SB(1, 1), b3 + hstepB, voffB); PG8_STAGE(PG8_SA(1, 0), a3, voffA);
            PG8_WAIT_V(8); PG8_WAIT_L(0); PG8_BAR; PG8_MMA(1, 0, At, B0); PG8_MMA(1, 1, At, B1); PG8_BAR; PG8_SCHED;
#else
            PG8_LDB(B0, 0, 0); PG8_SCHED; PG8_LDA(At, 0, 0); PG8_STAGE(PG8_SA(1, 1), a1 + hstepA, voffA);
            PG8_WAIT_L(8); PG8_BAR; PG8_WAIT_L(0); PG8_MMA(0, 0, At, B0); PG8_BAR; PG8_SCHED;
            PG8_LDB(B1, 0, 1); PG8_STAGE(PG8_SB(0, 0), b2, voffB);
            PG8_BAR; PG8_WAIT_L(0); PG8_MMA(0, 1, At, B1); PG8_BAR;
            PG8_LDA(At, 0, 1); PG8_STAGE(PG8_SA(0, 0), a2, voffA);
            PG8_BAR; PG8_WAIT_L(0); PG8_MMA(1, 0, At, B0); PG8_BAR; PG8_SCHED;
            PG8_STAGE(PG8_SB(0, 1), b2 + hstepB, voffB);
            PG8_WAIT_V(6); PG8_BAR; PG8_MMA(1, 1, At, B1); PG8_BAR;
            PG8_LDB(B0, 1, 0); PG8_SCHED; PG8_LDA(At, 1, 0); PG8_STAGE(PG8_SA(0, 1), a2 + hstepA, voffA);
            PG8_WAIT_L(8); PG8_BAR; PG8_WAIT_L(0); PG8_MMA(0, 0, At, B0); PG8_BAR; PG8_SCHED;
            PG8_LDB(B1, 1, 1); PG8_STAGE(PG8_SB(1, 0), b3, voffB);
            PG8_BAR; PG8_WAIT_L(0); PG8_MMA(0, 1, At, B1); PG8_BAR;
            PG8_LDA(At, 1, 1); PG8_STAGE(PG8_SA(1, 0), a3, voffA);
            PG8_BAR; PG8_WAIT_L(0); PG8_MMA(1, 0, At, B0); PG8_BAR; PG8_SCHED;
            PG8_STAGE(PG8_SB(1, 1), b3 + hstepB, voffB);
            PG8_WAIT_V(6); PG8_BAR; PG8_MMA(1, 1, At, B1); PG8_BAR;
#endif
        }
#endif
#if ALIGN_EPI
        if (wr == 0) PG8_BAR;
#endif
#if PG8_SP2 && ACC_ZERO_MFMA && EARLY_FRAG
        if constexpr (ACC_ZERO_SEL(Epi)) { if (EARLY_FRAG & 1) { PG8_LDB(B0, 0, 0); PG8_LDB(B1, 0, 1); PG8_SCHED; } if (EARLY_FRAG & 2) { PG8_LDA(At, 0, 0); } }
#endif
        E(acc, cur, wr, wc, fr, fq);
#ifdef EPI2X
        if constexpr (Epi::TWICE) { asm volatile("" ::: "memory"); E(acc, cur, wr, wc, fr, fq); }
#endif
        if (!has_next) break;
        if constexpr (!(ACC_ZERO_MFMA && PG8_SP2 && ACC_ZERO_SEL(Epi))) {
#pragma unroll
        for (int a = 0; a < 2; ++a)
#pragma unroll
            for (int b = 0; b < 2; ++b)
#pragma unroll
                for (int m = 0; m < 4; ++m)
#pragma unroll
                    for (int n = 0; n < 2; ++n) acc[a][b][m][n] = (f32x4){0.f, 0.f, 0.f, 0.f};
        }
        cur = nxt; cA = nA; cB = nB; ++ui;
#if ALIGN_EPI
        if (wr == 1) PG8_BAR;
#endif
    }
#if !ALIGN_EPI
    if (wr == 0) PG8_BAR;
#endif
    PG8_WAIT_V(0);
    PG8_BAR;
#undef PG8_NEXT
#undef PG8_K0A
#undef PG8_K0B
#undef PG8_SA
#undef PG8_SB
#undef PG8_STAGE
#undef PG8_LDA
#undef PG8_LDB
#undef PG8_MMA
#undef PG8_WAIT_V
#undef PG8_WAIT_L
#undef PG8_BAR
#undef PG8_SCHED
}
}
#ifndef ATT_EARLY_KV
#define ATT_EARLY_KV 0
#endif
#ifndef Q2_IMG
#define Q2_IMG 0
#endif
#ifndef AO_IMG
#define AO_IMG 0
#endif
namespace att {
#define ATT_LAS __attribute__((address_space(3)))
typedef unsigned short bf16_t;
using bf16x8 = __attribute__((ext_vector_type(8))) short;
using s16x4  = __attribute__((ext_vector_type(4))) short;
using f32x16 = __attribute__((ext_vector_type(16))) float;
using f32x4v = __attribute__((ext_vector_type(4))) float;
using u32x4  = __attribute__((ext_vector_type(4))) unsigned;
constexpr int NW = 8, QBLK = 32, KVBLK = 64;
constexpr float THR = 8.f;
constexpr int SHM_V = KVBLK * 128 * 2;
#define SBAR() __builtin_amdgcn_sched_barrier(0)
__device__ __forceinline__ int crow(int r, int hi) { return (r & 3) + 8 * (r >> 2) + 4 * hi; }
__device__ __forceinline__ unsigned cvtpk(float lo, float hi) { unsigned r; asm volatile("v_cvt_pk_bf16_f32 %0, %1, %2" : "=v"(r) : "v"(lo), "v"(hi)); return r; }
__device__ __forceinline__ float bflo(unsigned w) { return __uint_as_float(w << 16); }
__device__ __forceinline__ float bfhi(unsigned w) { return __uint_as_float(w & 0xffff0000u); }
#ifndef KSWZ16
#define KSWZ16 1
#endif
template <int KP> __device__ __forceinline__ int kswz(int row, int colB) {
#if KSWZ16
    if constexpr (KP == 256) return row * KP + (colB ^ ((row & 15) << 4));
    else return row * KP + (colB ^ (((row >> 1) & 7) << 4));
#else
    return row * KP + (colB ^ ((row & 7) << 4));
#endif
}

struct AttnArgs {
    const bf16_t* Q; const bf16_t* K; const bf16_t* KR; const bf16_t* V; bf16_t* O;
    int ldq, ldk, ldkr, ldv, ldo;
    int seq;
    int t0;
    const float* cosT; const float* sinT;
    const float* qgain;
    int qcol0;
    int orow0, ocol0;
};

#ifndef MLA_NQR
#define MLA_NQR 7
#endif
template <int MODE> struct Cfg;
template <> struct Cfg<0> { static constexpr int DQK = 128; static constexpr float SCALE = 0.088388347648318440f; static constexpr int NLD = 4, NQR = 8; };
template <> struct Cfg<1> { static constexpr int DQK = 192; static constexpr float SCALE = 0.072168783648703220f; static constexpr int NLD = 5, NQR = MLA_NQR; };

template <int MODE> __device__ __forceinline__ void partialSM(f32x16& p0, f32x16& p1, float& m_reg, float& mn, float& alpha) {
    constexpr float SC = Cfg<MODE>::SCALE, C = SC * 1.4426950408889634f;
    float pmax = p0[0];
#pragma unroll
    for (int r = 1; r < 16; ++r) pmax = fmaxf(pmax, p0[r]);
#pragma unroll
    for (int r = 0; r < 16; ++r) pmax = fmaxf(pmax, p1[r]);
    { auto rr = __builtin_amdgcn_permlane32_swap(__float_as_uint(pmax), __float_as_uint(pmax), false, false);
      pmax = fmaxf(__uint_as_float(rr[0]), __uint_as_float(rr[1])); }
    if (__builtin_expect(__all(pmax - m_reg <= THR / SC), 1)) { mn = m_reg; alpha = 1.f; }
    else { mn = fmaxf(m_reg, pmax); alpha = __builtin_amdgcn_exp2f((m_reg - mn) * C); m_reg = mn; }
    const float mnC = -mn * C;
#pragma unroll
    for (int r = 0; r < 16; ++r) p0[r] = fmaf(p0[r], C, mnC);
#pragma unroll
    for (int r = 0; r < 16; ++r) p1[r] = fmaf(p1[r], C, mnC);
#pragma unroll
    for (int r = 0; r < 16; ++r) p0[r] = __builtin_amdgcn_exp2f(p0[r]);
}
__device__ __forceinline__ void finishSM(f32x16& p0, f32x16& p1, float alpha, float& l_reg, bf16x8& pa0, bf16x8& pa1, bf16x8& pa2, bf16x8& pa3) {
#pragma unroll
    for (int r = 0; r < 16; ++r) p1[r] = __builtin_amdgcn_exp2f(p1[r]);
    float ps = 0;
#pragma unroll
    for (int r = 0; r < 16; ++r) ps += p0[r];
#pragma unroll
    for (int r = 0; r < 16; ++r) ps += p1[r];
    { auto rr = __builtin_amdgcn_permlane32_swap(__float_as_uint(ps), __float_as_uint(ps), false, false);
      ps = __uint_as_float(rr[0]) + __uint_as_float(rr[1]); }
    l_reg = l_reg * alpha + ps;
#define PK4(P, BASE, OUT) do { unsigned a0 = cvtpk(P[BASE + 0], P[BASE + 1]), a1 = cvtpk(P[BASE + 2], P[BASE + 3]);   \
    unsigned b0 = cvtpk(P[BASE + 4], P[BASE + 5]), b1 = cvtpk(P[BASE + 6], P[BASE + 7]);                              \
    auto r0 = __builtin_amdgcn_permlane32_swap(a0, b0, false, false); auto r1 = __builtin_amdgcn_permlane32_swap(a1, b1, false, false); \
    u32x4 w = {r0[0], r1[0], r0[1], r1[1]}; OUT = __builtin_bit_cast(bf16x8, w); } while (0)
    PK4(p0, 0, pa0); PK4(p0, 8, pa1); PK4(p1, 0, pa2); PK4(p1, 8, pa3);
#undef PK4
}
template <int MODE> __device__ __forceinline__ void qkt(f32x16& p0, f32x16& p1, const ATT_LAS unsigned char* Ks, const bf16x8* qr, const ATT_LAS unsigned char* qx, int r32, int hi) {
    constexpr int DQK = Cfg<MODE>::DQK, KP = DQK * 2;
    p0 = f32x16{}; p1 = f32x16{};
#pragma unroll
    for (int d0 = 0; d0 < DQK / 16; ++d0) { const int cb = (d0 * 16 + hi * 8) * 2;
        const bf16x8 b0 = *(const ATT_LAS bf16x8*)(Ks + kswz<KP>(r32, cb));
        const bf16x8 b1 = *(const ATT_LAS bf16x8*)(Ks + kswz<KP>(32 + r32, cb));
        constexpr int NQR = Cfg<MODE>::NQR;
        const bf16x8 q = d0 < NQR ? qr[d0 < NQR ? d0 : 0] : *(const ATT_LAS bf16x8*)(qx + (d0 - NQR) * 1024);
        p0 = __builtin_amdgcn_mfma_f32_32x32x16_bf16(b0, q, p0, 0, 0, 0);
        p1 = __builtin_amdgcn_mfma_f32_32x32x16_bf16(b1, q, p1, 0, 0, 0); }
}
__device__ __forceinline__ int v_st(int k, int c) { const int kk = (k & ~0xC) | ((k & 4) << 1) | ((k & 8) >> 1); return ((kk >> 3) * 4 + (c >> 5)) * 512 + ((kk & 7) * 32 + (c & 31)) * 2; }
__device__ __forceinline__ int v_rd_base(int lane) { return ((lane & 3) << 3) | (((lane >> 2) & 3) << 6) | (((lane >> 4) & 1) << 5) | (((lane >> 5) & 1) << 8); }
constexpr int v_rd_off(int d0, int ks, int half) { return d0 * 512 + ks * 4096 + half * 2048; }
template <int OFF> __device__ __forceinline__ s16x4 tr_read(int vb) {
    s16x4 r; asm volatile("ds_read_b64_tr_b16 %0, %1 offset:%2" : "=&v"(r) : "v"(vb), "i"(OFF) : "memory"); return r;
}
template <int D0> __device__ __forceinline__ void pv_one(f32x16& od, int vb, bf16x8 pa0, bf16x8 pa1, bf16x8 pa2, bf16x8 pa3) {
    const s16x4 l0 = tr_read<v_rd_off(D0, 0, 0)>(vb), h0 = tr_read<v_rd_off(D0, 0, 1)>(vb), l1 = tr_read<v_rd_off(D0, 1, 0)>(vb), h1 = tr_read<v_rd_off(D0, 1, 1)>(vb);
    const s16x4 l2 = tr_read<v_rd_off(D0, 2, 0)>(vb), h2 = tr_read<v_rd_off(D0, 2, 1)>(vb), l3 = tr_read<v_rd_off(D0, 3, 0)>(vb), h3 = tr_read<v_rd_off(D0, 3, 1)>(vb);
    asm volatile("s_waitcnt lgkmcnt(0)" ::: "memory"); SBAR();
#define PK(L, H) (bf16x8){L[0], L[1], L[2], L[3], H[0], H[1], H[2], H[3]}
    od = __builtin_amdgcn_mfma_f32_32x32x16_bf16(pa0, PK(l0, h0), od, 0, 0, 0);
    od = __builtin_amdgcn_mfma_f32_32x32x16_bf16(pa1, PK(l1, h1), od, 0, 0, 0);
    od = __builtin_amdgcn_mfma_f32_32x32x16_bf16(pa2, PK(l2, h2), od, 0, 0, 0);
    od = __builtin_amdgcn_mfma_f32_32x32x16_bf16(pa3, PK(l3, h3), od, 0, 0, 0);
#undef PK
}
__device__ __forceinline__ void pv_d0(f32x16* o, int vb, bf16x8 pa0, bf16x8 pa1, bf16x8 pa2, bf16x8 pa3) {
    pv_one<0>(o[0], vb, pa0, pa1, pa2, pa3); pv_one<1>(o[1], vb, pa0, pa1, pa2, pa3); pv_one<2>(o[2], vb, pa0, pa1, pa2, pa3); pv_one<3>(o[3], vb, pa0, pa1, pa2, pa3);
}
#ifndef ATT_ILVQ
#define ATT_ILVQ 0
#endif
#ifndef ATT_ILVQ_PF
#define ATT_ILVQ_PF 0
#endif
#ifndef ATT_ILVP
#define ATT_ILVP 3
#endif
template <int MODE, int D0> __device__ __forceinline__ void fs_slice(f32x16& p0, f32x16& p1, float& ps, float alpha, float& l_reg, bf16x8& pa0, bf16x8& pa1, bf16x8& pa2, bf16x8& pa3) {
    constexpr int N = Cfg<MODE>::DQK / 16;
#define PK4(P, BASE, OUT) do { unsigned a0 = cvtpk(P[BASE + 0], P[BASE + 1]), a1 = cvtpk(P[BASE + 2], P[BASE + 3]);   \
    unsigned b0 = cvtpk(P[BASE + 4], P[BASE + 5]), b1 = cvtpk(P[BASE + 6], P[BASE + 7]);                              \
    auto r0 = __builtin_amdgcn_permlane32_swap(a0, b0, false, false); auto r1 = __builtin_amdgcn_permlane32_swap(a1, b1, false, false); \
    u32x4 w = {r0[0], r1[0], r0[1], r1[1]}; OUT = __builtin_bit_cast(bf16x8, w); } while (0)
    if constexpr (D0 < 4) {
#pragma unroll
        for (int r = 0; r < 4; ++r) p1[D0 * 4 + r] = __builtin_amdgcn_exp2f(p1[D0 * 4 + r]);
    } else if constexpr (N == 12 && D0 < 8) {
#pragma unroll
        for (int r = 0; r < 4; ++r) { ps += p0[(D0 - 4) * 4 + r]; ps += p1[(D0 - 4) * 4 + r]; }
    } else if constexpr (N == 8 && D0 < 6) {
#pragma unroll
        for (int r = 0; r < 8; ++r) { ps += p0[(D0 - 4) * 8 + r]; ps += p1[(D0 - 4) * 8 + r]; }
    } else {
        constexpr int F = D0 - (N == 12 ? 8 : 6);
        if constexpr (F == 0) { auto rr = __builtin_amdgcn_permlane32_swap(__float_as_uint(ps), __float_as_uint(ps), false, false);
            ps = __uint_as_float(rr[0]) + __uint_as_float(rr[1]); l_reg = l_reg * alpha + ps; }
        if constexpr (N == 12) { if constexpr (F == 0) PK4(p0, 0, pa0); else if constexpr (F == 1) PK4(p0, 8, pa1); else if constexpr (F == 2) PK4(p1, 0, pa2); else PK4(p1, 8, pa3); }
        else { if constexpr (F == 0) { PK4(p0, 0, pa0); PK4(p0, 8, pa1); } else { PK4(p1, 0, pa2); PK4(p1, 8, pa3); } }
    }
#undef PK4
}
template <int MODE, int D0> __device__ __forceinline__ void qkfs_step(f32x16& n0, f32x16& n1, const ATT_LAS unsigned char* Ks, const bf16x8* qr, const ATT_LAS unsigned char* qx, int r32, int hi,
        bf16x8 kb0, bf16x8 kb1, bf16x8 qc, f32x16& p0, f32x16& p1, float& ps, float alpha, float& l_reg, bf16x8& pa0, bf16x8& pa1, bf16x8& pa2, bf16x8& pa3) {
    constexpr int DQK = Cfg<MODE>::DQK, KP = DQK * 2, N = DQK / 16, NQR = Cfg<MODE>::NQR;
#if ATT_ILVQ_PF
    bf16x8 nb0 = kb0, nb1 = kb1, qn = qc;
    if constexpr (D0 + 1 < N) { const int cb = ((D0 + 1) * 16 + hi * 8) * 2;
        nb0 = *(const ATT_LAS bf16x8*)(Ks + kswz<KP>(r32, cb)); nb1 = *(const ATT_LAS bf16x8*)(Ks + kswz<KP>(32 + r32, cb));
        if constexpr (D0 + 1 >= NQR) qn = *(const ATT_LAS bf16x8*)(qx + (D0 + 1 - NQR) * 1024); }
    bf16x8 q = qc; if constexpr (D0 < NQR) q = qr[D0 < NQR ? D0 : 0];
#else
    { const int cb = (D0 * 16 + hi * 8) * 2; kb0 = *(const ATT_LAS bf16x8*)(Ks + kswz<KP>(r32, cb)); kb1 = *(const ATT_LAS bf16x8*)(Ks + kswz<KP>(32 + r32, cb)); }
    bf16x8 q; if constexpr (D0 < NQR) q = qr[D0 < NQR ? D0 : 0]; else q = *(const ATT_LAS bf16x8*)(qx + (D0 - NQR) * 1024);
    const bf16x8 nb0 = kb0, nb1 = kb1, qn = qc;
#endif
    if constexpr (D0 == 0) { n0 = __builtin_amdgcn_mfma_f32_32x32x16_bf16(kb0, q, f32x16{}, 0, 0, 0); n1 = __builtin_amdgcn_mfma_f32_32x32x16_bf16(kb1, q, f32x16{}, 0, 0, 0); }
    else { n0 = __builtin_amdgcn_mfma_f32_32x32x16_bf16(kb0, q, n0, 0, 0, 0); n1 = __builtin_amdgcn_mfma_f32_32x32x16_bf16(kb1, q, n1, 0, 0, 0); }
    fs_slice<MODE, D0>(p0, p1, ps, alpha, l_reg, pa0, pa1, pa2, pa3);
    SBAR();
    if constexpr (D0 + 1 < N) qkfs_step<MODE, D0 + 1>(n0, n1, Ks, qr, qx, r32, hi, nb0, nb1, qn, p0, p1, ps, alpha, l_reg, pa0, pa1, pa2, pa3);
}
template <int MODE> __device__ __forceinline__ void qkt_fs(f32x16& n0, f32x16& n1, const ATT_LAS unsigned char* Ks, const bf16x8* qr, const ATT_LAS unsigned char* qx, int r32, int hi,
        f32x16& p0, f32x16& p1, float alpha, float& l_reg, bf16x8& pa0, bf16x8& pa1, bf16x8& pa2, bf16x8& pa3) {
    constexpr int KP = Cfg<MODE>::DQK * 2, NQR = Cfg<MODE>::NQR;
    const int cb = (hi * 8) * 2;
    const bf16x8 kb0 = *(const ATT_LAS bf16x8*)(Ks + kswz<KP>(r32, cb)), kb1 = *(const ATT_LAS bf16x8*)(Ks + kswz<KP>(32 + r32, cb));
    bf16x8 qc = kb0; if constexpr (NQR == 0) qc = *(const ATT_LAS bf16x8*)(qx);
    float ps = 0.f;
    qkfs_step<MODE, 0>(n0, n1, Ks, qr, qx, r32, hi, kb0, kb1, qc, p0, p1, ps, alpha, l_reg, pa0, pa1, pa2, pa3);
}
template <int MODE> __device__ __forceinline__ void pv_ps(f32x16* o, int vb, bf16x8 pa0, bf16x8 pa1, bf16x8 pa2, bf16x8 pa3, f32x16& p0, f32x16& p1, float& m_reg, float& mn, float& alpha) {
    constexpr float SC = Cfg<MODE>::SCALE, C = SC * 1.4426950408889634f;
    pv_one<0>(o[0], vb, pa0, pa1, pa2, pa3);
    float pmax = p0[0];
#pragma unroll
    for (int r = 1; r < 16; ++r) pmax = fmaxf(pmax, p0[r]);
#pragma unroll
    for (int r = 0; r < 16; ++r) pmax = fmaxf(pmax, p1[r]);
    { auto rr = __builtin_amdgcn_permlane32_swap(__float_as_uint(pmax), __float_as_uint(pmax), false, false);
      pmax = fmaxf(__uint_as_float(rr[0]), __uint_as_float(rr[1])); }
    pv_one<1>(o[1], vb, pa0, pa1, pa2, pa3);
    const bool keep = __all(pmax - m_reg <= THR / SC);
    const float mx = fmaxf(m_reg, pmax);
    mn = keep ? m_reg : mx;
    const float al = __builtin_amdgcn_exp2f((m_reg - mn) * C);
    alpha = keep ? 1.f : al; m_reg = mn;
    const float mnC = -mn * C;
#pragma unroll
    for (int r = 0; r < 16; ++r) p0[r] = fmaf(p0[r], C, mnC);
#pragma unroll
    for (int r = 0; r < 4; ++r) p0[r] = __builtin_amdgcn_exp2f(p0[r]);
    pv_one<2>(o[2], vb, pa0, pa1, pa2, pa3);
#pragma unroll
    for (int r = 0; r < 16; ++r) p1[r] = fmaf(p1[r], C, mnC);
#pragma unroll
    for (int r = 4; r < 10; ++r) p0[r] = __builtin_amdgcn_exp2f(p0[r]);
    pv_one<3>(o[3], vb, pa0, pa1, pa2, pa3);
#pragma unroll
    for (int r = 10; r < 16; ++r) p0[r] = __builtin_amdgcn_exp2f(p0[r]);
    asm volatile("" : "+v"(p0), "+v"(p1));
    SBAR();
}
__device__ __forceinline__ void rope8(float (&y)[8], const f32x4v c, const f32x4v s) {
#pragma unroll
    for (int p = 0; p < 4; ++p) { const float x0 = y[2 * p], x1 = y[2 * p + 1]; y[2 * p] = x0 * c[p] - x1 * s[p]; y[2 * p + 1] = x0 * s[p] + x1 * c[p]; }
}
__device__ __forceinline__ void unpack8(const u32x4 w, float (&y)[8]) { y[0] = bflo(w.x); y[1] = bfhi(w.x); y[2] = bflo(w.y); y[3] = bfhi(w.y); y[4] = bflo(w.z); y[5] = bfhi(w.z); y[6] = bflo(w.w); y[7] = bfhi(w.w); }
__device__ __forceinline__ u32x4 pack8(const float (&y)[8]) { u32x4 w; w.x = cvtpk(y[0], y[1]); w.y = cvtpk(y[2], y[3]); w.z = cvtpk(y[4], y[5]); w.w = cvtpk(y[6], y[7]); return w; }

template <int MODE, int SDEPTH>
__device__ __forceinline__ void attn_unit(const AttnArgs& a, ATT_LAS unsigned char* lds, const int wid  ) {
    constexpr int DQK = Cfg<MODE>::DQK, KP = DQK * 2, SHM_K = KVBLK * KP, ND0 = DQK / 16;
    int lane = hw_lane(); asm volatile("" : "+v"(lane));
    const int tid = wid * 64 + lane, r32 = lane & 31, hi = lane >> 5;
    ATT_LAS unsigned char* V_lds = lds; ATT_LAS unsigned char* K_lds = lds + 2 * SHM_V;
    ATT_LAS float* wsf = (ATT_LAS float*)(lds + 2 * SHM_V + 2 * SHM_K) + wid * 64; ATT_LAS float* li_l = wsf; ATT_LAS float* al_l = wsf + 32;
    float m_reg = -1e30f, l_reg = 0; f32x16 o[4] = {}; bf16x8 qr[8];
    constexpr int NQR = Cfg<MODE>::NQR, QXB = (12 - NQR) * 1024;
    ATT_LAS unsigned char* qx = lds + 2 * SHM_V + 2 * SHM_K + 2048 + wid * QXB + lane * 16;
    const int sr = tid >> 4, sc = (tid & 15) * 8, vst0 = v_st(sr, sc), vst1 = v_st(32 + sr, sc);
    const int kst0 = kswz<KP>(sr, sc * 2), kst1 = kswz<KP>(32 + sr, sc * 2);
    const int krr = tid >> 3, krc = (tid & 7) * 8, kst2 = kswz<KP>(krr, (128 + krc) * 2);
    const int vb0 = (int)(unsigned)(uintptr_t)V_lds + v_rd_base(lane);
    const char* Kh = (const char*)a.K; const char* Vh = (const char*)a.V; const char* KRh = (const char*)a.KR;
    const unsigned offK = (unsigned)(sr * a.ldk + sc) * 2u, offV = (unsigned)(sr * a.ldv + sc) * 2u, offR = (unsigned)(krr * a.ldkr + krc) * 2u;
    const size_t tK = (size_t)a.ldk * (2 * KVBLK), tV = (size_t)a.ldv * (2 * KVBLK), tR = (size_t)a.ldkr * (2 * KVBLK);
    struct { bf16x8 vs0, vs1, ks0, ks1, kr; } sr_[SDEPTH];
#define SLOAD(i, j) do { const char* vb_ = Vh + (size_t)(j) * tV; const char* kb_ = Kh + (size_t)(j) * tK; \
    sr_[i].vs0 = *(const bf16x8*)(vb_ + offV); sr_[i].vs1 = *(const bf16x8*)(vb_ + (tV >> 1) + offV); \
    sr_[i].ks0 = *(const bf16x8*)(kb_ + offK); sr_[i].ks1 = *(const bf16x8*)(kb_ + (tK >> 1) + offK); \
    if constexpr (MODE == 1) sr_[i].kr = *(const bf16x8*)(KRh + (size_t)(j) * tR + offR); } while (0)
#define SWRITE(b, i) do { *(ATT_LAS bf16x8*)(V_lds + (b) * SHM_V + vst0) = sr_[i].vs0; *(ATT_LAS bf16x8*)(V_lds + (b) * SHM_V + vst1) = sr_[i].vs1; \
    *(ATT_LAS bf16x8*)(K_lds + (b) * SHM_K + kst0) = sr_[i].ks0; *(ATT_LAS bf16x8*)(K_lds + (b) * SHM_K + kst1) = sr_[i].ks1; \
    if constexpr (MODE == 1) *(ATT_LAS bf16x8*)(K_lds + (b) * SHM_K + kst2) = sr_[i].kr; } while (0)
#define SWAIT() do { if constexpr (SDEPTH == 1) asm volatile("s_waitcnt vmcnt(0)" ::: "memory"); else if constexpr (MODE == 1) asm volatile("s_waitcnt vmcnt(5)" ::: "memory"); else asm volatile("s_waitcnt vmcnt(4)" ::: "memory"); } while (0)
#define RESC(al) do { if (__any((al) < 1.f)) { if (hi == 0) al_l[r32] = (al); asm volatile("s_waitcnt lgkmcnt(0)" ::: "memory"); \
    _Pragma("unroll") for (int d = 0; d < 4; ++d) _Pragma("unroll") for (int r = 0; r < 16; ++r) o[d][r] *= al_l[crow(r, hi)]; } } while (0)
    f32x16 pA0, pA1, pB0, pB1; float mnA, mnB, alA, alB; bf16x8 pa0, pa1, pa2, pa3; const int NT = a.seq / KVBLK;
    constexpr int SE = 0, SO = SDEPTH - 1;
#if ATT_EARLY_KV
    SLOAD(SE, 0);
#endif
    {
        int tq = hw_lane(); asm volatile("" : "+v"(tq)); const int r32 = tq & 31, hi = (tq >> 5) & 1;
        const bf16_t* Qw = a.Q + (long)(wid * QBLK + r32) * a.ldq + hi * 8;
#if Q2_IMG
#define QSRC(d0_) (MODE == 1 ? (const void*)((const char*)a.Q + pg8::img_off(a.orow0 + wid * QBLK + r32, a.qcol0 + (d0_) * 16 + hi * 8, 3072)) : (const void*)(Qw + (d0_) * 16))
#else
#define QSRC(d0_) ((const void*)(Qw + (d0_) * 16))
#endif
        const int t = a.t0 + wid * QBLK + r32;
        if constexpr (MODE == 0) {
            u32x4 raw[8]; float ss = 0.f;
#pragma unroll
            for (int d0 = 0; d0 < 8; ++d0) { raw[d0] = *(const u32x4*)(Qw + d0 * 16); float y[8]; unpack8(raw[d0], y);
#pragma unroll
                for (int e = 0; e < 8; ++e) ss += y[e] * y[e]; }
            ss += __shfl_xor(ss, 32);
            const float rstd = 1.0f / sqrtf(ss * (1.0f / 128.0f) + 1e-6f);
#pragma unroll
            for (int d0 = 0; d0 < 8; ++d0) { float y[8]; unpack8(raw[d0], y);
                const f32x4v g0 = *(const f32x4v*)(a.qgain + d0 * 16 + hi * 8), g1 = *(const f32x4v*)(a.qgain + d0 * 16 + hi * 8 + 4);
#pragma unroll
                for (int e = 0; e < 4; ++e) { y[e] = y[e] * rstd * g0[e]; y[4 + e] = y[4 + e] * rstd * g1[e]; }
                if (a.t0 >= 0) { const f32x4v c = *(const f32x4v*)(a.cosT + (long)t * 64 + d0 * 8 + hi * 4), s = *(const f32x4v*)(a.sinT + (long)t * 64 + d0 * 8 + hi * 4); rope8(y, c, s); }
                qr[d0] = __builtin_bit_cast(bf16x8, pack8(y)); }
        } else {
            ATT_LAS unsigned char* qxw = lds + 2 * SHM_V + 2 * SHM_K + 2048 + wid * QXB + (tq & 63) * 16;
#pragma unroll
            for (int d0 = 0; d0 < 8; ++d0) { const bf16x8 v = *(const bf16x8*)QSRC(d0); if (d0 < NQR) qr[d0 < NQR ? d0 : 0] = v; else *(ATT_LAS bf16x8*)(qxw + (d0 - NQR) * 1024) = v; }
#pragma unroll
            for (int d0 = 8; d0 < 12; ++d0) { const u32x4 raw = *(const u32x4*)QSRC(d0); float y[8]; unpack8(raw, y);
                const f32x4v c = *(const f32x4v*)(a.cosT + (long)t * 32 + (d0 - 8) * 8 + hi * 4), s = *(const f32x4v*)(a.sinT + (long)t * 32 + (d0 - 8) * 8 + hi * 4); rope8(y, c, s);
                *(ATT_LAS u32x4*)(qxw + (d0 - NQR) * 1024) = pack8(y); }
            asm volatile("s_waitcnt lgkmcnt(0)" ::: "memory");
        }
    }
#if ATT_EARLY_KV
    asm volatile("s_waitcnt vmcnt(0)" ::: "memory"); SWRITE(0, SE); __syncthreads();
#else
    SLOAD(SE, 0); asm volatile("s_waitcnt vmcnt(0)" ::: "memory"); SWRITE(0, SE); __syncthreads();
#endif
    qkt<MODE>(pA0, pA1, K_lds, qr, qx, r32, hi); partialSM<MODE>(pA0, pA1, m_reg, mnA, alA);
    SLOAD(SO, 1); if constexpr (SDEPTH == 2) { if (2 < NT) SLOAD(SE, 2); }
    SWAIT(); SWRITE(1, SO); __syncthreads();
    for (int j = 1; j + 1 < NT; j += 2) {
        if constexpr (SDEPTH == 1) { SLOAD(SO, j + 1); }
        constexpr bool ILVQ = ((ATT_ILVQ >> MODE) & 1) != 0, ILVP = ((ATT_ILVP >> MODE) & 1) != 0;
        SBAR(); if constexpr (ILVQ) qkt_fs<MODE>(pB0, pB1, K_lds + SHM_K, qr, qx, r32, hi, pA0, pA1, alA, l_reg, pa0, pa1, pa2, pa3);
        else { qkt<MODE>(pB0, pB1, K_lds + SHM_K, qr, qx, r32, hi); finishSM(pA0, pA1, alA, l_reg, pa0, pa1, pa2, pa3); } SBAR();
        if constexpr (SDEPTH == 2) { SLOAD(SO, j + SDEPTH); } SBAR();
        if constexpr (ILVP) pv_ps<MODE>(o, vb0, pa0, pa1, pa2, pa3, pB0, pB1, m_reg, mnB, alB);
        else { pv_d0(o, vb0, pa0, pa1, pa2, pa3); partialSM<MODE>(pB0, pB1, m_reg, mnB, alB); }
        __syncthreads(); SWAIT(); SWRITE(0, SE);
        RESC(alB); __syncthreads();
        if constexpr (SDEPTH == 1) { SLOAD(SE, j + 2); }
        SBAR(); if constexpr (ILVQ) qkt_fs<MODE>(pA0, pA1, K_lds, qr, qx, r32, hi, pB0, pB1, alB, l_reg, pa0, pa1, pa2, pa3);
        else { qkt<MODE>(pA0, pA1, K_lds, qr, qx, r32, hi); finishSM(pB0, pB1, alB, l_reg, pa0, pa1, pa2, pa3); } SBAR();
        if constexpr (SDEPTH == 2) { if (j + 3 < NT) SLOAD(SE, j + 1 + SDEPTH); } SBAR();
        if constexpr (ILVP) pv_ps<MODE>(o, vb0 + SHM_V, pa0, pa1, pa2, pa3, pA0, pA1, m_reg, mnA, alA);
        else { pv_d0(o, vb0 + SHM_V, pa0, pa1, pa2, pa3); partialSM<MODE>(pA0, pA1, m_reg, mnA, alA); }
        __syncthreads(); SWAIT(); SWRITE(1, SO);
        RESC(alA); __syncthreads();
    }
    SBAR(); qkt<MODE>(pB0, pB1, K_lds + SHM_K, qr, qx, r32, hi);
    finishSM(pA0, pA1, alA, l_reg, pa0, pa1, pa2, pa3); SBAR();
    pv_d0(o, vb0, pa0, pa1, pa2, pa3); partialSM<MODE>(pB0, pB1, m_reg, mnB, alB);
    __syncthreads(); RESC(alB);
    finishSM(pB0, pB1, alB, l_reg, pa0, pa1, pa2, pa3); SBAR();
    pv_d0(o, vb0 + SHM_V, pa0, pa1, pa2, pa3);
    int te = hw_lane(); asm volatile("" : "+v"(te));
    { const int lane = te & 63, r32 = lane & 31, hi = lane >> 5;
    if (hi == 0) li_l[r32] = l_reg; asm volatile("s_waitcnt lgkmcnt(0)" ::: "memory");
    float rli[16];
#pragma unroll
    for (int r = 0; r < 16; ++r) rli[r] = __builtin_amdgcn_rcpf(li_l[crow(r, hi)]);
    __syncthreads();
    ATT_LAS bf16_t* stg = (ATT_LAS bf16_t*)lds + wid * 4096;
#pragma unroll
    for (int r = 0; r < 16; ++r) { const int orow = crow(r, hi);
#pragma unroll
        for (int d0 = 0; d0 < 4; ++d0) stg[orow * 128 + d0 * 32 + r32] = (bf16_t)(cvtpk(o[d0][r] * rli[r], 0.f) & 0xffffu); }
    asm volatile("s_waitcnt lgkmcnt(0)" ::: "memory");
#if AO_IMG
    {
      const int ch = lane & 15, C = a.ocol0 + ch * 8;
#pragma unroll
      for (int i = 0; i < 8; ++i) { const int row = i * 4 + (lane >> 4), R = a.orow0 + wid * QBLK + row; const u32x4 v = *(const ATT_LAS u32x4*)(stg + row * 128 + ch * 8);
          *(u32x4*)((char*)a.O + pg8::img_off(R, C, 2048)) = v; } }
#else
    { char* Ow = (char*)(a.O + (size_t)(wid * QBLK) * a.ldo); const unsigned offO = (unsigned)((lane >> 4) * a.ldo + (lane & 15) * 8) * 2u; const size_t rO = (size_t)a.ldo * 8;
#pragma unroll
      for (int i = 0; i < 8; ++i) { const int row = i * 4 + (lane >> 4), ch = lane & 15; const u32x4 v = *(const ATT_LAS u32x4*)(stg + row * 128 + ch * 8); *(u32x4*)(Ow + i * rO + offO) = v; } }
#endif
    }
    asm volatile("s_waitcnt lgkmcnt(0)" ::: "memory");
    __syncthreads();
#undef SLOAD
#undef SWRITE
#undef SWAIT
#undef RESC
}

constexpr int NST = 3, KN_B = 16384, V_B = 16384, KR_B = 8192, OFF_KN = 0, OFF_V = NST * KN_B, OFF_KR = OFF_V + NST * V_B, OFF_WS = OFF_KR + NST * KR_B, ATT_DMA_LDS = OFF_WS + 2048;
template <int MODE> __device__ __forceinline__ void qkt2(f32x16& p0, f32x16& p1, const ATT_LAS unsigned char* Kn, const ATT_LAS unsigned char* Kr, const bf16x8* qr, int r32, int hi) {
    p0 = f32x16{}; p1 = f32x16{};
    const int x = (r32 & 7) << 4;
#pragma unroll
    for (int d0 = 0; d0 < 8; ++d0) { const int cb = (d0 * 16 + hi * 8) * 2;
        const bf16x8 b0 = *(const ATT_LAS bf16x8*)(Kn + r32 * 256 + (cb ^ x));
        const bf16x8 b1 = *(const ATT_LAS bf16x8*)(Kn + (32 + r32) * 256 + (cb ^ x));
        p0 = __builtin_amdgcn_mfma_f32_32x32x16_bf16(b0, qr[d0], p0, 0, 0, 0);
        p1 = __builtin_amdgcn_mfma_f32_32x32x16_bf16(b1, qr[d0], p1, 0, 0, 0); }
    if constexpr (MODE == 1) {
#pragma unroll
        for (int d0 = 8; d0 < 12; ++d0) { const int cb = ((d0 - 8) * 16 + hi * 8) * 2;
            const bf16x8 b0 = *(const ATT_LAS bf16x8*)(Kr + r32 * 128 + (cb ^ x));
            const bf16x8 b1 = *(const ATT_LAS bf16x8*)(Kr + (32 + r32) * 128 + (cb ^ x));
            p0 = __builtin_amdgcn_mfma_f32_32x32x16_bf16(b0, qr[d0], p0, 0, 0, 0);
            p1 = __builtin_amdgcn_mfma_f32_32x32x16_bf16(b1, qr[d0], p1, 0, 0, 0); }
    }
}
template <int MODE, bool STAG>
__device__ __forceinline__ void attn_unit_dma(const AttnArgs& a, ATT_LAS unsigned char* lds, const int wid  ) {
    constexpr int ND0 = Cfg<MODE>::DQK / 16;
    int lane = hw_lane(); asm volatile("" : "+v"(lane));
    const int r32 = lane & 31, hi = lane >> 5;
    ATT_LAS float* wsf = (ATT_LAS float*)(lds + OFF_WS) + wid * 64; ATT_LAS float* li_l = wsf; ATT_LAS float* al_l = wsf + 32;
    const char* Kh = (const char*)a.K; const char* Vh = (const char*)a.V; const char* KRh = (const char*)a.KR;
    const size_t tK = (size_t)a.ldk * (2 * KVBLK), tV = (size_t)a.ldv * (2 * KVBLK), tR = (size_t)a.ldkr * (2 * KVBLK);
    unsigned offKn[2], offVv[2], offKr;
#pragma unroll
    for (int i = 0; i < 2; ++i) { const int p = wid + 8 * i;
        { const int row = p * 4 + (lane >> 4), src = (lane & 15) ^ (row & 7); offKn[i] = (unsigned)(row * a.ldk) * 2u + (unsigned)src * 16u; }
        { const int sI = p * 2 + (lane >> 5), q = lane & 31, kk = (sI >> 2) * 8 + (q >> 2), col = (sI & 3) * 32 + (q & 3) * 8, k = (kk & ~0xC) | ((kk & 4) << 1) | ((kk & 8) >> 1);
          offVv[i] = (unsigned)(k * a.ldv + col) * 2u; } }
    { const int row = wid * 8 + (lane >> 3), src = (lane & 7) ^ (row & 7); offKr = (unsigned)(row * a.ldkr) * 2u + (unsigned)src * 16u; }
#define DMA16(gp, lp) __builtin_amdgcn_global_load_lds((const unsigned*)(gp), (ATT_LAS unsigned*)(lp), 16, 0, 0)
#define ISSUE_K(j, st) do { const char* kb_ = Kh + (size_t)(j) * tK; DMA16(kb_ + offKn[0], lds + OFF_KN + (st) * KN_B + wid * 1024); DMA16(kb_ + offKn[1], lds + OFF_KN + (st) * KN_B + (wid + 8) * 1024); \
    if constexpr (MODE == 1) DMA16(KRh + (size_t)(j) * tR + offKr, lds + OFF_KR + (st) * KR_B + wid * 1024); } while (0)
#define ISSUE_V(j, st) do { const char* vb_ = Vh + (size_t)(j) * tV; DMA16(vb_ + offVv[0], lds + OFF_V + (st) * V_B + wid * 1024); DMA16(vb_ + offVv[1], lds + OFF_V + (st) * V_B + (wid + 8) * 1024); } while (0)
#define WAIT_TILE(full) do { if (full) { if constexpr (MODE == 1) asm volatile("s_waitcnt vmcnt(5)" ::: "memory"); else asm volatile("s_waitcnt vmcnt(4)" ::: "memory"); } else asm volatile("s_waitcnt vmcnt(0)" ::: "memory"); \
    asm volatile("s_waitcnt lgkmcnt(0)" ::: "memory"); __builtin_amdgcn_s_barrier(); asm volatile("" ::: "memory"); } while (0)
    const int NT = a.seq / KVBLK;
    ISSUE_K(0, 0); ISSUE_V(0, 0); ISSUE_K(1, 1);
    float m_reg = -1e30f, l_reg = 0; f32x16 o[4] = {}; bf16x8 qr[ND0];
    {
        int tq = hw_lane(); asm volatile("" : "+v"(tq)); const int r32 = tq & 31, hi = (tq >> 5) & 1;
        const bf16_t* Qw = a.Q + (long)(wid * QBLK + r32) * a.ldq + hi * 8;
        const int t = a.t0 + wid * QBLK + r32;
        if constexpr (MODE == 0) {
            u32x4 raw[8]; float ss = 0.f;
#pragma unroll
            for (int d0 = 0; d0 < 8; ++d0) { raw[d0] = *(const u32x4*)(Qw + d0 * 16); float y[8]; unpack8(raw[d0], y);
#pragma unroll
                for (int e = 0; e < 8; ++e) ss += y[e] * y[e]; }
            ss += __shfl_xor(ss, 32);
            const float rstd = 1.0f / sqrtf(ss * (1.0f / 128.0f) + 1e-6f);
#pragma unroll
            for (int d0 = 0; d0 < 8; ++d0) { float y[8]; unpack8(raw[d0], y);
                const f32x4v g0 = *(const f32x4v*)(a.qgain + d0 * 16 + hi * 8), g1 = *(const f32x4v*)(a.qgain + d0 * 16 + hi * 8 + 4);
#pragma unroll
                for (int e = 0; e < 4; ++e) { y[e] = y[e] * rstd * g0[e]; y[4 + e] = y[4 + e] * rstd * g1[e]; }
                if (a.t0 >= 0) { const f32x4v c = *(const f32x4v*)(a.cosT + (long)t * 64 + d0 * 8 + hi * 4), s = *(const f32x4v*)(a.sinT + (long)t * 64 + d0 * 8 + hi * 4); rope8(y, c, s); }
                qr[d0] = __builtin_bit_cast(bf16x8, pack8(y)); }
        } else {
#pragma unroll
            for (int d0 = 0; d0 < 8; ++d0) qr[d0] = *(const bf16x8*)(Qw + d0 * 16);
#pragma unroll
            for (int d0 = 8; d0 < 12; ++d0) { const u32x4 raw = *(const u32x4*)(Qw + d0 * 16); float y[8]; unpack8(raw, y);
                const f32x4v c = *(const f32x4v*)(a.cosT + (long)t * 32 + (d0 - 8) * 8 + hi * 4), s = *(const f32x4v*)(a.sinT + (long)t * 32 + (d0 - 8) * 8 + hi * 4); rope8(y, c, s);
                qr[d0] = __builtin_bit_cast(bf16x8, pack8(y)); }
        }
    }
    const int vb0 = (int)(unsigned)(uintptr_t)(lds + OFF_V) + v_rd_base(lane);
    const ATT_LAS unsigned char* Kn0 = lds + OFF_KN; const ATT_LAS unsigned char* Kr0 = lds + OFF_KR;
#define RESC(al) do { if (__any((al) < 1.f)) { if (hi == 0) al_l[r32] = (al); asm volatile("s_waitcnt lgkmcnt(0)" ::: "memory"); \
    _Pragma("unroll") for (int d = 0; d < 4; ++d) _Pragma("unroll") for (int r = 0; r < 16; ++r) o[d][r] *= al_l[crow(r, hi)]; } } while (0)
    f32x16 pA0, pA1, pB0, pB1; float mnA, mnB, alA, alB; bf16x8 pa0, pa1, pa2, pa3;
    asm volatile("s_waitcnt vmcnt(0)" ::: "memory"); __builtin_amdgcn_s_barrier(); asm volatile("" ::: "memory");
    int sj = 1;
    const bool isB = STAG && wid >= 4;
#define TILE(S0, S1, mnS, alS, P0, P1, mnP, alP, j) do { \
    const int s_cur = sj, s_prev = (sj == 0 ? 2 : sj - 1), s_next = (sj == 2 ? 0 : sj + 1); \
    if ((j) + 2 < NT) ISSUE_K((j) + 2, s_prev); \
    if ((j) + 1 < NT) ISSUE_V((j) + 1, s_next); \
    if (isB) { partialSM<MODE>(P0, P1, m_reg, mnP, alP); RESC(alP); } \
    SBAR(); qkt2<MODE>(S0, S1, Kn0 + s_cur * KN_B, Kr0 + s_cur * KR_B, qr, r32, hi); \
    finishSM(P0, P1, alP, l_reg, pa0, pa1, pa2, pa3); SBAR(); \
    pv_d0(o, vb0 + s_prev * V_B, pa0, pa1, pa2, pa3); \
    if (!isB) { partialSM<MODE>(S0, S1, m_reg, mnS, alS); RESC(alS); } \
    WAIT_TILE((j) + 2 < NT); \
    sj = s_next; } while (0)
    if (2 < NT) ISSUE_K(2, 2);
    ISSUE_V(1, 1);
    SBAR(); qkt2<MODE>(pA0, pA1, Kn0, Kr0, qr, r32, hi); if (!isB) partialSM<MODE>(pA0, pA1, m_reg, mnA, alA);
    WAIT_TILE(2 < NT);
    for (int j = 1; j + 1 < NT; j += 2) {
        TILE(pB0, pB1, mnB, alB, pA0, pA1, mnA, alA, j);
        TILE(pA0, pA1, mnA, alA, pB0, pB1, mnB, alB, j + 1);
    }
    TILE(pB0, pB1, mnB, alB, pA0, pA1, mnA, alA, NT - 1);
    if (isB) { partialSM<MODE>(pB0, pB1, m_reg, mnB, alB); RESC(alB); }
    { const int s_prev = (sj == 0 ? 2 : sj - 1);
      finishSM(pB0, pB1, alB, l_reg, pa0, pa1, pa2, pa3); SBAR();
      pv_d0(o, vb0 + s_prev * V_B, pa0, pa1, pa2, pa3); }
    int te = hw_lane(); asm volatile("" : "+v"(te));
    { const int lane = te & 63, r32 = lane & 31, hi = lane >> 5;
    if (hi == 0) li_l[r32] = l_reg; asm volatile("s_waitcnt lgkmcnt(0)" ::: "memory");
    float rli[16];
#pragma unroll
    for (int r = 0; r < 16; ++r) rli[r] = __builtin_amdgcn_rcpf(li_l[crow(r, hi)]);
    asm volatile("s_waitcnt lgkmcnt(0)" ::: "memory"); __builtin_amdgcn_s_barrier(); asm volatile("" ::: "memory");
    ATT_LAS bf16_t* stg = (ATT_LAS bf16_t*)lds + wid * 4096;
#pragma unroll
    for (int r = 0; r < 16; ++r) { const int orow = crow(r, hi);
#pragma unroll
        for (int d0 = 0; d0 < 4; ++d0) stg[orow * 128 + d0 * 32 + r32] = (bf16_t)(cvtpk(o[d0][r] * rli[r], 0.f) & 0xffffu); }
    asm volatile("s_waitcnt lgkmcnt(0)" ::: "memory");
#if AO_IMG
    {
      const int ch = lane & 15, C = a.ocol0 + ch * 8;
#pragma unroll
      for (int i = 0; i < 8; ++i) { const int row = i * 4 + (lane >> 4), R = a.orow0 + wid * QBLK + row; const u32x4 v = *(const ATT_LAS u32x4*)(stg + row * 128 + ch * 8);
          *(u32x4*)((char*)a.O + pg8::img_off(R, C, 2048)) = v; } }
#else
    { char* Ow = (char*)(a.O + (size_t)(wid * QBLK) * a.ldo); const unsigned offO = (unsigned)((lane >> 4) * a.ldo + (lane & 15) * 8) * 2u; const size_t rO = (size_t)a.ldo * 8;
#pragma unroll
      for (int i = 0; i < 8; ++i) { const int row = i * 4 + (lane >> 4), ch = lane & 15; const u32x4 v = *(const ATT_LAS u32x4*)(stg + row * 128 + ch * 8); *(u32x4*)(Ow + i * rO + offO) = v; } }
#endif
    }
    asm volatile("s_waitcnt vmcnt(0) lgkmcnt(0)" ::: "memory"); __builtin_amdgcn_s_barrier(); asm volatile("" ::: "memory");
#undef DMA16
#undef ISSUE_K
#undef ISSUE_V
#undef WAIT_TILE
#undef RESC
#undef TILE
}
#undef SBAR
}
constexpr int NWAVES = 8;
constexpr int DM = 2048, NB = 8, SEQL = 2048, CTXL = 256, SROW = SEQL + CTXL  , MT = NB * SROW  , DFF = 5632, NMODC = 9 * DM  ;
constexpr int HYB_IN = 4608, MLA_DP = 1536  , MLA_QW = 3072, MLA_KVW = 4096;
constexpr float EPS = 1e-6f;
#ifndef IMG_H
#define IMG_H 1
#endif
constexpr int IMG_NAT = IMG_H ? 16 : 0, IMG_PERM = IMG_H ? 32 : 0;
#ifndef HIN_DEFER
#define HIN_DEFER 0
#endif
#ifndef ATT_DMA
#define ATT_DMA 0
#endif
#ifndef ATT_STAG
#define ATT_STAG 1
#endif
#ifndef DOWN_KREV
#define DOWN_KREV 0
#endif
#ifndef MK_PER_PHASE
#define MK_PER_PHASE 0
#endif

constexpr size_t MiB = 1u << 20;
constexpr size_t WS_CTL = 0, CTL_ZERO_BYTES = 1 * MiB;
constexpr size_t WS_MODV = 1 * MiB;
constexpr size_t WS_ROPE = 3 * MiB;
constexpr size_t WS_W = 5 * MiB;
constexpr size_t SZ_WGU = (size_t)2 * DFF * DM * 2, SZ_WD = (size_t)DM * DFF * 2;
constexpr size_t WS_WGU = WS_W;
constexpr size_t WS_WD = WS_WGU + 4 * SZ_WGU;
constexpr size_t WS_WHIN = WS_WD + 4 * SZ_WD;
constexpr size_t WS_WHOUT = WS_WHIN + (size_t)HYB_IN * DM * 2;
constexpr size_t WS_WMDOWN = WS_WHOUT + (size_t)DM * DM * 2;
constexpr size_t WS_WMUQ = WS_WMDOWN + (size_t)MLA_DP * DM * 2;
constexpr size_t WS_WMUKV = WS_WMUQ + (size_t)MLA_QW * 768 * 2;
constexpr size_t WS_WMO = WS_WMUKV + (size_t)MLA_KVW * 512 * 2;
constexpr size_t WS_WEND = WS_WMO + (size_t)DM * DM * 2;
constexpr size_t WS_X = 318 * MiB;
constexpr size_t WS_XN = WS_X + (size_t)MT * DM * 4;
constexpr size_t WS_H = WS_XN + (size_t)MT * DM * 2;
#ifndef KV_PAD
#define KV_PAD 0
#endif
constexpr size_t WS_CD = (KV_PAD && XH) ? WS_X + (size_t)MT * DM * 2   : WS_H + (size_t)MT * MLA_KVW * 2;
constexpr size_t WS_Q2 = WS_H + (size_t)MT * DFF * 2;
constexpr size_t WS_END = WS_Q2 + (size_t)MT * MLA_QW * 2;
#ifndef BATCH_LOCAL
#define BATCH_LOCAL 0
#endif
constexpr int U_LD = BATCH_LOCAL ? DFF : HYB_IN, KV_LD = BATCH_LOCAL ? DFF : MLA_KVW + ((KV_PAD && XH) ? KV_PAD : 0), CD_LD = BATCH_LOCAL ? DFF : MLA_DP;
constexpr size_t WS_P = BATCH_LOCAL ? WS_END + 16 * MiB : WS_Q2;
constexpr size_t WS_AO = HIN_DEFER ? WS_END + 16 * MiB : WS_XN;
constexpr size_t WS_TOTAL = WS_END + 16 * MiB + (HIN_DEFER ? (size_t)MT * DM * 2 : 0) + (BATCH_LOCAL ? 64 * MiB : 0);
static_assert(!(HIN_DEFER && BATCH_LOCAL), "pick one");
static_assert(WS_WEND <= WS_X, "weights fit below X");
static_assert((KV_PAD && XH) ? (WS_CD + (size_t)MT * MLA_DP * 2 <= WS_XN && (size_t)MT * KV_LD * 2 <= (size_t)MT * DFF * 2) : (WS_CD + (size_t)MT * MLA_DP * 2 <= WS_Q2), "KV inside the H region, CD inside the H region or the free half of the X region");
constexpr int CW_BAR = 4096;

#ifndef LDS_BIG
#define LDS_BIG 0
#endif
constexpr int RING_OFF = 0, RING_BYTES = LDS_BIG ? 158720 : 131072;
constexpr int LDSCTL_OFF = RING_BYTES, MISC_OFF = LDSCTL_OFF + 320;
constexpr int LDS_BYTES = LDS_BIG ? 159744 : 147456;
static_assert(MISC_OFF + 128 <= LDS_BYTES, "LDS map");

#define GAS __attribute__((address_space(1)))
#define LAS __attribute__((address_space(3)))
typedef unsigned short bf16;
typedef unsigned v4u __attribute__((ext_vector_type(4)));
typedef unsigned v2u __attribute__((ext_vector_type(2)));
typedef float f32x4 __attribute__((ext_vector_type(4)));
typedef GAS unsigned gu32;
#define RLX_AGENT __ATOMIC_RELAXED, __HIP_MEMORY_SCOPE_AGENT
#define LDS_WAIT() asm volatile("s_waitcnt lgkmcnt(0)" ::: "memory")
#define VM_WAIT() asm volatile("s_waitcnt vmcnt(0)" ::: "memory")
__device__ __forceinline__ unsigned pk2(float lo, float hi) { unsigned r; asm volatile("v_cvt_pk_bf16_f32 %0, %1, %2" : "=v"(r) : "v"(lo), "v"(hi)); return r; }
__device__ __forceinline__ float bflo(unsigned w) { return __uint_as_float(w << 16); }
__device__ __forceinline__ float bfhi(unsigned w) { return __uint_as_float(w & 0xffff0000u); }
__device__ __forceinline__ void unpack8(const v4u w, float (&y)[8]) { y[0] = bflo(w.x); y[1] = bfhi(w.x); y[2] = bflo(w.y); y[3] = bfhi(w.y); y[4] = bflo(w.z); y[5] = bfhi(w.z); y[6] = bflo(w.w); y[7] = bfhi(w.w); }
__device__ __forceinline__ v4u pack8(const float (&y)[8]) { v4u w; w.x = pk2(y[0], y[1]); w.y = pk2(y[2], y[3]); w.z = pk2(y[4], y[5]); w.w = pk2(y[6], y[7]); return w; }

#ifndef BAR_EARLY_REL
#define BAR_EARLY_REL 0
#endif
#ifndef BAR_WG_REL
#define BAR_WG_REL 0
#endif
#define XB_TMO      128
#define XB_XCNT(j)  (256  + 64 * (j))
#define XB_XSUB(j)  (1280 + 64 * (j))
#define XB_XGEN(j)  (2304 + 64 * (j))
#define XB_TOP      3328
#define XB_TOPGEN   3392
#define XCD_BAR_WORDS 3456
#define XB_SPIN_CAP (1u << 20)

__device__ __forceinline__ unsigned xb_ld(unsigned* p)              { return __hip_atomic_load(p, __ATOMIC_RELAXED, __HIP_MEMORY_SCOPE_AGENT); }
__device__ __forceinline__ unsigned xb_add(unsigned* p, unsigned v) { return __hip_atomic_fetch_add(p, v, __ATOMIC_RELAXED, __HIP_MEMORY_SCOPE_AGENT); }
__device__ __forceinline__ unsigned xb_xcc_id() { return (unsigned)__builtin_amdgcn_s_getreg((3 << 11) | 20) & 0xFu; }
#define XB_SPIN(cond, bar) do { unsigned _sp = 0; while (cond) { __builtin_amdgcn_s_sleep(1); \
    if ((++_sp & 255u) == 0u) { if (xb_ld(&(bar)[XB_TMO])) break; if (_sp > XB_SPIN_CAP) { atomicAdd(&(bar)[XB_TMO], 1u); break; } } } } while (0)

struct XcdBarrier {
    unsigned* bar; unsigned x;
    volatile LAS unsigned* st;
};
__device__ __forceinline__ XcdBarrier xcd_barrier_post(unsigned* bar, volatile LAS unsigned* st, bool leader  ) {
    XcdBarrier b; b.bar = bar; b.x = xb_xcc_id(); b.st = st;
    if (leader) (void)xb_add(&bar[XB_XCNT(b.x)], 1u);
    return b;
}
__device__ __forceinline__ void xcd_barrier_complete(unsigned* bar, unsigned x, unsigned& nloc, unsigned& nx) {
    const unsigned G = gridDim.x * gridDim.y * gridDim.z;
    unsigned sum, cnt, mine, sp = 0u;
    for (;;) {
        sum = 0u; cnt = 0u; mine = 0u;
#pragma unroll
        for (unsigned j = 0; j < 16; ++j) { const unsigned c = xb_ld(&bar[XB_XCNT(j)]); sum += c; cnt += (c > 0u) ? 1u : 0u; mine = (j == x) ? c : mine; }
        if (sum == G) break;
        __builtin_amdgcn_s_sleep(1);
        if ((++sp & 255u) == 0u) { if (xb_ld(&bar[XB_TMO])) break; if (sp > XB_SPIN_CAP) { atomicAdd(&bar[XB_TMO], 1u); break; } }
    }
    nloc = mine > 0u ? mine : 1u; nx = cnt > 0u ? cnt : 1u;
}
__device__ __forceinline__ void xcd_barrier(const XcdBarrier& b, bool leader  ) {
    asm volatile("s_waitcnt vmcnt(0)" ::: "memory");
    __syncthreads();
    if (leader) {
        unsigned* bar = b.bar;
        __builtin_amdgcn_s_waitcnt(0);
        unsigned nloc = b.st[0], nx = b.st[1];
        if (nloc == 0u) { xcd_barrier_complete(bar, b.x, nloc, nx); b.st[0] = nloc; b.st[1] = nx; }
#if BAR_WG_REL
        __builtin_amdgcn_fence(__ATOMIC_RELEASE, "agent");
        asm volatile("s_waitcnt vmcnt(0)" ::: "memory");
#endif
        const unsigned old = xb_add(&bar[XB_XSUB(b.x)], 1u);
        const unsigned gen = old / nloc;
        if (old + 1u == (gen + 1u) * nloc) {
#if !BAR_WG_REL
            __builtin_amdgcn_fence(__ATOMIC_RELEASE, "agent");
            asm volatile("s_waitcnt vmcnt(0)" ::: "memory");
#endif
            const unsigned og = xb_add(&bar[XB_TOP], 1u);
            const unsigned tg = og / nx;
            if (og + 1u == (tg + 1u) * nx) xb_add(&bar[XB_TOPGEN], 1u);
            else XB_SPIN(xb_ld(&bar[XB_TOPGEN]) == tg, bar);
#if BAR_EARLY_REL
            asm volatile("" ::: "memory");
            xb_add(&bar[XB_XGEN(b.x)], 1u);
            __builtin_amdgcn_fence(__ATOMIC_ACQUIRE, "agent");
            asm volatile("s_waitcnt vmcnt(0)" ::: "memory");
#else
            __builtin_amdgcn_fence(__ATOMIC_ACQUIRE, "agent");
            xb_add(&bar[XB_XGEN(b.x)], 1u);
            asm volatile("s_waitcnt vmcnt(0)" ::: "memory");
#endif
        } else {
            XB_SPIN(xb_ld(&bar[XB_XGEN(b.x)]) == gen, bar);
            __builtin_amdgcn_fence(__ATOMIC_ACQUIRE, "agent");
            asm volatile("s_waitcnt vmcnt(0)" ::: "memory");
        }
    }
    __syncthreads();
}

__device__ __forceinline__ void xcd_barrier_local(const XcdBarrier& b, bool leader) {
    asm volatile("s_waitcnt vmcnt(0)" ::: "memory");
    __syncthreads();
    if (leader) {
        unsigned* bar = b.bar;
        __builtin_amdgcn_s_waitcnt(0);
        unsigned nloc = b.st[0], nx = b.st[1];
        if (nloc == 0u) { xcd_barrier_complete(bar, b.x, nloc, nx); b.st[0] = nloc; b.st[1] = nx; }
        const unsigned old = xb_add(&bar[XB_XSUB(b.x)], 1u);
        const unsigned gen = old / nloc;
        if (old + 1u == (gen + 1u) * nloc) { xb_add(&bar[XB_XGEN(b.x)], 1u); }
        else XB_SPIN(xb_ld(&bar[XB_XGEN(b.x)]) == gen, bar);
        __builtin_amdgcn_fence(__ATOMIC_ACQUIRE, "agent");
        asm volatile("s_waitcnt vmcnt(0)" ::: "memory");
    }
    __syncthreads();
}
struct Args { const float* in[27]; float* out; unsigned char* ws; int ph_lo, ph_hi; };
struct Frame {
    LAS unsigned char* lds;
    volatile LAS unsigned* MISC;
    int wave, vcu, G;
    unsigned char* ws;
};
__device__ __forceinline__ float wave_sum(float v) {
#pragma unroll
    for (int o = 1; o < 64; o <<= 1) v += __shfl_xor(v, o);
    return v;
}

#ifndef P0_NT
#define P0_NT 0
#endif
#ifndef P0_LD16
#define P0_LD16 0
#endif
__device__ __forceinline__ void p0_transpose_item(const float* W, int N, bf16* WT, int dK, int k0, int n0, int drow0, LAS float* scr, int lane, int img  ) {
#if P0_LD16
    f32x4 t_[8];
    const float* wp = W + (size_t)(k0 + (lane >> 3)) * N + n0 + (lane & 7) * 4;
#pragma unroll
    for (int i = 0; i < 8; ++i) t_[i] = *(const f32x4*)(wp + (size_t)(8 * i) * N);
#pragma unroll
    for (int i = 0; i < 8; ++i) { LAS float* d = scr + (8 * i + (lane >> 3)) * 33 + (lane & 7) * 4; d[0] = t_[i].x; d[1] = t_[i].y; d[2] = t_[i].z; d[3] = t_[i].w; }
#else
    float t_[32];
    const float* wp = W + (size_t)(k0 + (lane >> 5)) * N + n0 + (lane & 31);
#pragma unroll
    for (int i = 0; i < 32; ++i) t_[i] = P0_NT ? __builtin_nontemporal_load(wp + (size_t)(2 * i) * N) : wp[(size_t)(2 * i) * N];
#pragma unroll
    for (int i = 0; i < 32; ++i) scr[(2 * i + (lane >> 5)) * 33 + (lane & 31)] = t_[i];
#endif
    LDS_WAIT(); asm volatile("" ::: "memory");
    const int c = lane & 7;
#pragma unroll
    for (int j = 0; j < 4; ++j) { const int n = (lane >> 3) + 8 * j; const LAS float* s = scr + (8 * c) * 33 + n;
        v4u o; o.x = pk2(s[0 * 33], s[1 * 33]); o.y = pk2(s[2 * 33], s[3 * 33]); o.z = pk2(s[4 * 33], s[5 * 33]); o.w = pk2(s[6 * 33], s[7 * 33]);
        const int dr = drow0 + n;
        if (img == 0) *(v4u*)(WT + (size_t)dr * dK + k0 + 8 * c) = o;
        else *(v4u*)((char*)WT + pg8::img_off(img == 3 ? pg8::img_row_perm_adj(dr) : (img == 2 ? pg8::img_row_perm(dr) : dr), k0 + 8 * c, dK)) = o; }
    LDS_WAIT(); asm volatile("" ::: "memory");
}
#ifndef RES_PERM
#define RES_PERM 2
#endif
static_assert(RES_PERM != 2 || IMG_H, "adjacent column halves need the image-layout weight copies");
#define IMG_RES (RES_PERM == 2 ? (IMG_H ? 48 : 0) : (RES_PERM ? IMG_PERM : IMG_NAT))
struct WDesc { int in_idx, src_off, K, N, mode; unsigned dst_mib2; int items; };
#define WD_FFN(l, f) {9 + 3 * (f) + 0, (l) * DM * DFF, DM, DFF, 1 + IMG_PERM, (unsigned)((WS_WGU + ((l) * 2 + (f)) * SZ_WGU) / (MiB / 2)), (DM / 64) * (DFF / 32)}, \
                     {9 + 3 * (f) + 1, (l) * DM * DFF, DM, DFF, 2 + IMG_PERM, (unsigned)((WS_WGU + ((l) * 2 + (f)) * SZ_WGU) / (MiB / 2)), (DM / 64) * (DFF / 32)}, \
                     {9 + 3 * (f) + 2, (l) * DM * DFF, DFF, DM, IMG_RES, (unsigned)((WS_WD + ((l) * 2 + (f)) * SZ_WD) / (MiB / 2)), (DFF / 64) * (DM / 32)}
__constant__ WDesc g_wdesc[18] = {
    WD_FFN(0, 0), WD_FFN(0, 1), WD_FFN(1, 0), WD_FFN(1, 1),
    {15, 0, DM, HYB_IN, IMG_PERM, (unsigned)(WS_WHIN / (MiB / 2)), (DM / 64) * (HYB_IN / 32)},
    {19, 0, DM, DM, IMG_RES, (unsigned)(WS_WHOUT / (MiB / 2)), (DM / 64) * (DM / 32)},
    {20, 0, DM, 1344, IMG_PERM, (unsigned)(WS_WMDOWN / (MiB / 2)), (DM / 64) * (1344 / 32)},
    {23, 0, 768, MLA_QW, IMG_PERM, (unsigned)(WS_WMUQ / (MiB / 2)), (768 / 64) * (MLA_QW / 32)},
    {24, 0, 512, MLA_KVW, IMG_PERM, (unsigned)(WS_WMUKV / (MiB / 2)), (512 / 64) * (MLA_KVW / 32)},
    {25, 0, DM, DM, IMG_RES, (unsigned)(WS_WMO / (MiB / 2)), (DM / 64) * (DM / 32)},
};
static_assert(WS_WGU % (MiB / 2) == 0 && SZ_WGU % (MiB / 2) == 0 && WS_WD % (MiB / 2) == 0 && SZ_WD % (MiB / 2) == 0 && WS_WHIN % (MiB / 2) == 0 && WS_WHOUT % (MiB / 2) == 0 && WS_WMDOWN % (MiB / 2) == 0 &&
              WS_WMUQ % (MiB / 2) == 0 && WS_WMUKV % (MiB / 2) == 0 && WS_WMO % (MiB / 2) == 0, "weight copies on half-MiB boundaries");
__device__ __forceinline__ void bg_transposes(Frame& F, const Args& args, int d0, int d1, int rank, int nranks, int it_lo = 0, int it_hi = 1 << 30) {
    FRESH_LANE(lane);
    LAS float* scr = (LAS float*)(F.lds + RING_OFF + F.wave * 16384);
    int total = 0;
#pragma unroll 1
    for (int j = d0; j < d1; ++j) total += g_wdesc[j].items;
    if (it_hi < total) total = it_hi;
    for (int it = it_lo + rank; it < total; it += nranks) {
        int r = it, j = d0;
#pragma unroll 1
        while (r >= g_wdesc[j].items) { r -= g_wdesc[j].items; ++j; }
        const WDesc d = g_wdesc[j];
        const int nblk = d.N / 32, kb = r / nblk, nb = r - kb * nblk, n0 = 32 * nb;
        const int rm = d.mode & 3, drow0 = rm == 0 ? n0 : ((n0 >> 7) * 256 + (rm == 2 ? 128 : 0) + (n0 & 127));
        p0_transpose_item(args.in[d.in_idx] + (size_t)d.src_off, d.N, (bf16*)(F.ws + (size_t)d.dst_mib2 * (MiB / 2)), d.K, 64 * kb, n0, drow0, scr, lane, d.mode >> 4);
    }
}
constexpr int MG_NB = 576, MG_NBLK = NMODC / MG_NB  , MG_KB = 256, MG_KBLK = DM / MG_KB  ;
constexpr size_t WS_MPART = WS_END;
__device__ __forceinline__ void mod_gemv_partial(Frame& F, const Args& args, int layer, int rank, int nranks) {
    FRESH_LANE(lane); const int tid = F.wave * 64 + lane;
    LAS float* st = (LAS float*)(F.lds + RING_OFF);
    LAS float* part = (LAS float*)(F.lds + RING_OFF + 73728);
    const float* cin = args.in[1]; const float* cctx = args.in[3]; const float* mw = args.in[4];
    float* PART = (float*)(F.ws + WS_MPART) + (size_t)layer * MG_KBLK * 9 * NMODC;
    if (rank >= MG_KBLK * MG_NBLK) return;
    for (int i = tid; i < 9 * DM; i += NWAVES * 64) { const int r = i >> 11, k = i & 2047; const float v = r < 8 ? cin[r * DM + k] : cctx[k]; st[i] = v / (1.0f + expf(-v)); }
    __syncthreads();
    for (int item = rank; item < MG_KBLK * MG_NBLK; item += nranks) {
        const int kblk = item / MG_NBLK, nblk = item - kblk * MG_NBLK, n0 = nblk * MG_NB, k0 = kblk * MG_KB + F.wave * 32;
        const float* W = mw + (size_t)layer * DM * NMODC + (size_t)k0 * NMODC + n0 + lane * 4;
        f32x4 acc[3][9];
#pragma unroll
        for (int g = 0; g < 3; ++g)
#pragma unroll
            for (int r = 0; r < 9; ++r) acc[g][r] = (f32x4){0.f, 0.f, 0.f, 0.f};
#pragma unroll 4
        for (int i = 0; i < 32; ++i) {
            const float* wr_ = W + (size_t)i * NMODC;
            const f32x4 w0 = P0_NT ? __builtin_nontemporal_load((const f32x4*)(wr_)) : *(const f32x4*)(wr_), w1 = P0_NT ? __builtin_nontemporal_load((const f32x4*)(wr_ + 256)) : *(const f32x4*)(wr_ + 256);
            f32x4 w2 = (f32x4){0.f, 0.f, 0.f, 0.f}; if (lane < 16) w2 = P0_NT ? __builtin_nontemporal_load((const f32x4*)(wr_ + 512)) : *(const f32x4*)(wr_ + 512);
#pragma unroll
            for (int r = 0; r < 9; ++r) { const float sv = st[r * DM + k0 + i]; acc[0][r] += sv * w0; acc[1][r] += sv * w1; acc[2][r] += sv * w2; }
        }
#pragma unroll
        for (int r = 0; r < 9; ++r) {
            const f32x4 a0 = acc[0][r], a1 = acc[1][r], a2 = acc[2][r];
            *(LAS f32x4*)(part + F.wave * MG_NB + lane * 4) = a0; *(LAS f32x4*)(part + F.wave * MG_NB + 256 + lane * 4) = a1; if (lane < 16) *(LAS f32x4*)(part + F.wave * MG_NB + 512 + lane * 4) = a2;
            __syncthreads();
            for (int c = tid; c < MG_NB; c += NWAVES * 64) { float s = 0.f;
#pragma unroll
                for (int w = 0; w < 8; ++w) s += part[w * MG_NB + c];
                PART[((size_t)kblk * 9 + r) * NMODC + n0 + c] = s; }
            __syncthreads();
        }
    }
}
__device__ __forceinline__ void mod_gemv_reduce(Frame& F, const Args& args, int layer, int rank_t, int nranks_t) {
    const float* mb = args.in[5]; const float* PART = (const float*)(F.ws + WS_MPART) + (size_t)layer * MG_KBLK * 9 * NMODC; float* MODV = (float*)(F.ws + WS_MODV);
    for (int i = rank_t; i < 9 * NMODC / 4; i += nranks_t) { const int r = i / (NMODC / 4), c4 = i - r * (NMODC / 4);
        f32x4 s = *(const f32x4*)(mb + (size_t)layer * NMODC + c4 * 4);
#pragma unroll
        for (int kb = 0; kb < MG_KBLK; ++kb) s += *(const f32x4*)(PART + ((size_t)kb * 9 + r) * NMODC + c4 * 4);
        *(f32x4*)(MODV + (size_t)(layer * 9 + r) * NMODC + c4 * 4) = s; }
}
__device__ __forceinline__ void p0_prologue(Frame& F, const Args& args) {
    FRESH_LANE(lane); const int tid = F.wave * 64 + lane; (void)tid;
    const int gw = F.vcu * NWAVES + F.wave, NGW = F.G * NWAVES, gt = gw * 64 + lane, NGT = NGW * 64;
    {
        bg_transposes(F, args, 0, 18, gw, NGW);
        for (int i = gt; i < (MLA_DP - 1344) * (DM / 8); i += NGT) { const int n = 1344 + i / (DM / 8), k = (i % (DM / 8)) * 8;
            char* zb = (char*)(F.ws + WS_WMDOWN);
            *(v4u*)(IMG_H ? zb + pg8::img_off(pg8::img_row_perm(n), k, DM) : zb + ((size_t)n * DM + k) * 2) = (v4u){0u, 0u, 0u, 0u}; }
    }
    {
        float* cosA = (float*)(F.ws + WS_ROPE); float* sinA = cosA + SEQL * 64; float* cosM = sinA + SEQL * 64; float* sinM = cosM + SEQL * 32;
        for (int i = gt; i < SEQL * 96; i += NGT) {
            const int t = i / 96, e = i - t * 96; const bool isA = e < 64; const int p = isA ? e : e - 64, hp = isA ? 32 : 16;
            const int fi = p < hp ? p : p - hp; const float pos = (float)(p < hp ? (t >> 6) : (t & 63));
            const float inv = 1.0f / powf(10000.0f, (float)(2 * fi) / (float)(2 * hp));
            const float ang = pos * inv;
            if (isA) { cosA[t * 64 + p] = cosf(ang); sinA[t * 64 + p] = sinf(ang); } else { cosM[t * 32 + p] = cosf(ang); sinM[t * 32 + p] = sinf(ang); }
        }
    }
    __syncthreads();
    mod_gemv_partial(F, args, 0, (int)blockIdx.x, F.G);
    mod_gemv_partial(F, args, 1, (int)blockIdx.x, F.G);
}

__device__ __forceinline__ bool np_rowinfo(int k, int gw, int cpw, int lpw, int& b, int& s) {
    if (k < cpw) { const int cr = gw * cpw + k; if (cr >= NB * CTXL) return false; b = cr / CTXL; s = cr - b * CTXL; }
    else { const int lr = gw * lpw + (k - cpw); if (lr >= NB * SEQL) return false; b = lr / SEQL; s = CTXL + lr - b * SEQL; }
    return true;
}
#ifndef NORM16
#define NORM16 1
#endif
#if NORM16
#define NCOL(jj, l) (((jj) >> 1) * 512 + (l) * 8 + ((jj) & 1) * 4)
#else
#define NCOL(jj, l) ((jj) * 256 + (l) * 4)
#endif
__device__ __forceinline__ void np_ldx(const xres_t* rowp, int lane, f32x4 (&v)[8]) {
#if NORM16
#pragma unroll
    for (int j = 0; j < 4; ++j) xres_ld8(rowp + j * 512 + lane * 8, v[2 * j], v[2 * j + 1]);
#else
#pragma unroll
    for (int j = 0; j < 8; ++j) v[j] = xres_ld4(rowp + j * 256 + lane * 4);
#endif
}
__device__ __forceinline__ void np_stx(xres_t* rowp, int lane, const f32x4 (&v)[8]) {
#if NORM16
#pragma unroll
    for (int j = 0; j < 4; ++j) xres_st8(rowp + j * 512 + lane * 8, v[2 * j], v[2 * j + 1]);
#else
#pragma unroll
    for (int j = 0; j < 8; ++j) xres_st4(rowp + j * 256 + lane * 4, v[j]);
#endif
}
__device__ __forceinline__ void norm_phase(Frame& F, const float* gain, const float* modL, int shift_chunk, int scale_chunk, bool lat_only, bool pend, const float* xin, const float* cin, bool rm_probe = false) {
    FRESH_LANE(lane);
    const int gw = F.vcu * NWAVES + F.wave, NGW = F.G * NWAVES;
    const int cpw = (NB * CTXL + NGW - 1) / NGW, lpw = (NB * SEQL + NGW - 1) / NGW;
    xres_t* X = (xres_t*)(F.ws + WS_X); bf16* XN = (bf16*)(F.ws + WS_XN);
    f32x4 A[8], B[8]; int cur_r = -1;
    const int k0 = lat_only ? cpw : 0, k1 = cpw + lpw;
    int bn = 0, sn = 0; bool okn = (k0 < k1) && np_rowinfo(k0, gw, cpw, lpw, bn, sn); bool f32n = false;
    f32x4 vn[8];
#if XH
#if NORM16
    xh8_t hn[4];
#define NP_ISSUE_X() do { const xres_t* xs = X + (size_t)(bn * SROW + sn) * DM + lane * 8; _Pragma("unroll") for (int j = 0; j < 4; ++j) hn[j] = *(const xh8_t*)(xs + j * 512); } while (0)
#define NP_TAKE_X() do { _Pragma("unroll") for (int j = 0; j < 4; ++j) { const xf8_t t = __builtin_convertvector(hn[j], xf8_t); v[2 * j] = (f32x4){t[0], t[1], t[2], t[3]}; v[2 * j + 1] = (f32x4){t[4], t[5], t[6], t[7]}; } } while (0)
#else
    xh4_t hn[8];
#define NP_ISSUE_X() do { const xres_t* xs = X + (size_t)(bn * SROW + sn) * DM + lane * 4; _Pragma("unroll") for (int j = 0; j < 8; ++j) hn[j] = *(const xh4_t*)(xs + j * 256); } while (0)
#define NP_TAKE_X() do { _Pragma("unroll") for (int j = 0; j < 8; ++j) v[j] = __builtin_convertvector(hn[j], f32x4); } while (0)
#endif
#define NP_ISSUE() do { const float* in_ = sn < CTXL ? cin : xin; f32n = in_ != nullptr; \
        if (f32n) { const float* xs = in_ + (size_t)(sn < CTXL ? bn * CTXL + sn : bn * SEQL + sn - CTXL) * DM; _Pragma("unroll") for (int j = 0; j < 8; ++j) vn[j] = *(const f32x4*)(xs + NCOL(j, lane)); } \
        else NP_ISSUE_X(); } while (0)
#else
#define NP_ISSUE() do { const float* in_ = sn < CTXL ? cin : xin; f32n = true; \
        const float* xs = in_ ? in_ + (size_t)(sn < CTXL ? bn * CTXL + sn : bn * SEQL + sn - CTXL) * DM : X + (size_t)(bn * SROW + sn) * DM; \
        _Pragma("unroll") for (int j = 0; j < 8; ++j) vn[j] = *(const f32x4*)(xs + NCOL(j, lane)); } while (0)
#endif
    if (okn) NP_ISSUE();
    for (int k = k0; k < k1; ++k) {
        const bool ok = okn; const int b = bn, s = sn;
        f32x4 v[8];
#if XH
        if (f32n) {
#pragma unroll
            for (int j = 0; j < 8; ++j) v[j] = vn[j];
        } else NP_TAKE_X();
#else
#pragma unroll
        for (int j = 0; j < 8; ++j) v[j] = vn[j];
#endif
        okn = (k + 1 < k1) && np_rowinfo(k + 1, gw, cpw, lpw, bn, sn);
        if (okn) NP_ISSUE();
        if (!ok) continue;
        const int row = b * SROW + s, r = s < CTXL ? 8 : b;
        if (r != cur_r) { cur_r = r;
            const float* sc = modL + (size_t)r * NMODC + scale_chunk * DM; const float* sh = modL + (size_t)r * NMODC + shift_chunk * DM;
#pragma unroll
            for (int j = 0; j < 8; ++j) { const f32x4 g = *(const f32x4*)(gain + NCOL(j, lane)), s4 = *(const f32x4*)(sc + NCOL(j, lane));
                A[j] = g * (1.0f + s4); B[j] = *(const f32x4*)(sh + NCOL(j, lane)); } }
        float ss = 0.f;
        if (pend && s < CTXL) {
            const xres_t* pr = (const xres_t*)(F.ws + WS_P) + (size_t)(b * CTXL + s) * DM;
#pragma unroll
            for (int q = 0; q < 4; ++q) { f32x4 t[8]; np_ldx(pr + (size_t)q * (NB * CTXL) * DM, lane, t);
#pragma unroll
                for (int j = 0; j < 8; ++j) v[j] += t[j]; }
            np_stx(X + (size_t)row * DM, lane, v);
        }
#pragma unroll
        for (int j = 0; j < 8; ++j) ss += (v[j].x * v[j].x + v[j].y * v[j].y) + (v[j].z * v[j].z + v[j].w * v[j].w);
        const float rstd = 1.0f / sqrtf(wave_sum(ss) * (1.0f / DM) + EPS);
#if NORM16
#pragma unroll
        for (int j = 0; j < 4; ++j) { const f32x4 y0 = v[2 * j] * rstd * A[2 * j] + B[2 * j], y1 = v[2 * j + 1] * rstd * A[2 * j + 1] + B[2 * j + 1];
            v4u w; w.x = pk2(y0.x, y0.y); w.y = pk2(y0.z, y0.w); w.z = pk2(y1.x, y1.y); w.w = pk2(y1.z, y1.w);
            if (rm_probe) *(v4u*)((bf16*)(F.ws + WS_TOTAL + 16 * MiB) + (size_t)row * DM + j * 512 + lane * 8) = w; else
            if (IMG_H) *(v4u*)((char*)XN + pg8::img_off(row, j * 512 + lane * 8, DM)) = w; else *(v4u*)(XN + (size_t)row * DM + j * 512 + lane * 8) = w; }
#else
#pragma unroll
        for (int j = 0; j < 8; ++j) { const f32x4 y = v[j] * rstd * A[j] + B[j]; v2u w; w.x = pk2(y.x, y.y); w.y = pk2(y.z, y.w);
            if (IMG_H) *(v2u*)((char*)XN + pg8::img_off(row, j * 256 + lane * 4, DM)) = w; else *((v2u*)(XN + (size_t)row * DM) + lane + 64 * j) = w; }
#endif
    }
#undef NP_ISSUE
#if XH
#undef NP_ISSUE_X
#undef NP_TAKE_X
#endif
}
#if XH && NORM16
#ifndef NORM_D2
#define NORM_D2 0
#endif
__device__ __forceinline__ void norm_phase_d2(Frame& F, const float* gain, const float* modL, int shift_chunk, int scale_chunk, bool lat_only, bool pend, const float* cin) {
    FRESH_LANE(lane);
    const int gw = F.vcu * NWAVES + F.wave, NGW = F.G * NWAVES;
    const int cpw = (NB * CTXL + NGW - 1) / NGW, lpw = (NB * SEQL + NGW - 1) / NGW;
    xres_t* X = (xres_t*)(F.ws + WS_X); bf16* XN = (bf16*)(F.ws + WS_XN);
    f32x4 A[8], B[8]; int cur_r = -1;
    const int k0 = lat_only ? cpw : 0, k1 = cpw + lpw;
    xh8_t h0[4], h1[4]; f32x4 vn[8];
    bool ok0 = false, ok1 = false, f0 = false, f1 = false; int b0 = 0, s0 = 0, b1 = 0, s1 = 0;
#define NP2_ISSUE(kk, H, OK, BB, SS, FF) do { OK = ((kk) < k1) && np_rowinfo((kk), gw, cpw, lpw, BB, SS); FF = false; \
        if (OK) { if (cin && SS < CTXL) { FF = true; const float* xs = cin + (size_t)(BB * CTXL + SS) * DM; _Pragma("unroll") for (int j = 0; j < 8; ++j) vn[j] = *(const f32x4*)(xs + NCOL(j, lane)); } \
                  else { const xres_t* xs = X + (size_t)(BB * SROW + SS) * DM + lane * 8; _Pragma("unroll") for (int j = 0; j < 4; ++j) H[j] = *(const xh8_t*)(xs + j * 512); } } } while (0)
#define NP2_ROW(kk, H, OK, BB, SS, FF) do { \
        const bool ok = OK; const int b = BB, s = SS; f32x4 v[8]; \
        if (FF) { _Pragma("unroll") for (int j = 0; j < 8; ++j) v[j] = vn[j]; } \
        else { _Pragma("unroll") for (int j = 0; j < 4; ++j) { const xf8_t t = __builtin_convertvector(H[j], xf8_t); v[2 * j] = (f32x4){t[0], t[1], t[2], t[3]}; v[2 * j + 1] = (f32x4){t[4], t[5], t[6], t[7]}; } } \
        NP2_ISSUE((kk) + 2, H, OK, BB, SS, FF); \
        if (ok) { \
            const int row = b * SROW + s, r = s < CTXL ? 8 : b; \
            if (r != cur_r) { cur_r = r; \
                const float* sc = modL + (size_t)r * NMODC + scale_chunk * DM; const float* sh = modL + (size_t)r * NMODC + shift_chunk * DM; \
                _Pragma("unroll") for (int j = 0; j < 8; ++j) { const f32x4 g = *(const f32x4*)(gain + NCOL(j, lane)), s4 = *(const f32x4*)(sc + NCOL(j, lane)); \
                    A[j] = g * (1.0f + s4); B[j] = *(const f32x4*)(sh + NCOL(j, lane)); } } \
            if (pend && s < CTXL) { \
                const xres_t* pr = (const xres_t*)(F.ws + WS_P) + (size_t)(b * CTXL + s) * DM; \
                _Pragma("unroll") for (int q = 0; q < 4; ++q) { f32x4 t[8]; np_ldx(pr + (size_t)q * (NB * CTXL) * DM, lane, t); \
                    _Pragma("unroll") for (int j = 0; j < 8; ++j) v[j] += t[j]; } \
                np_stx(X + (size_t)row * DM, lane, v); } \
            float ss = 0.f; \
            _Pragma("unroll") for (int j = 0; j < 8; ++j) ss += (v[j].x * v[j].x + v[j].y * v[j].y) + (v[j].z * v[j].z + v[j].w * v[j].w); \
            const float rstd = 1.0f / sqrtf(wave_sum(ss) * (1.0f / DM) + EPS); \
            _Pragma("unroll") for (int j = 0; j < 4; ++j) { const f32x4 y0 = v[2 * j] * rstd * A[2 * j] + B[2 * j], y1 = v[2 * j + 1] * rstd * A[2 * j + 1] + B[2 * j + 1]; \
                v4u w; w.x = pk2(y0.x, y0.y); w.y = pk2(y0.z, y0.w); w.z = pk2(y1.x, y1.y); w.w = pk2(y1.z, y1.w); \
                if (IMG_H) *(v4u*)((char*)XN + pg8::img_off(row, j * 512 + lane * 8, DM)) = w; else *(v4u*)(XN + (size_t)row * DM + j * 512 + lane * 8) = w; } } } while (0)
    NP2_ISSUE(k0, h0, ok0, b0, s0, f0);
    NP2_ISSUE(k0 + 1, h1, ok1, b1, s1, f1);
    for (int k = k0; k < k1; k += 2) {
        NP2_ROW(k, h0, ok0, b0, s0, f0);
        NP2_ROW(k + 1, h1, ok1, b1, s1, f1);
    }
#undef NP2_ISSUE
#undef NP2_ROW
}
#endif
#if XT
__device__ __forceinline__ void norm_band_phase(Frame& F, const float* gain, const float* modL, int shift_chunk, int scale_chunk, bool lat_only, bool pend, const float* cin) {
    FRESH_LANE(lane);
    const int fr = lane & 15, fq = lane >> 4, w = F.wave, tid = w * 64 + lane;
    const unsigned loff = (unsigned)((fr * 64 + fq * 16) ^ ((fr >> 3) << 5));
    char* Xb = (char*)(F.ws + WS_X); char* XNb = (char*)(F.ws + WS_XN); const char* Pb = (const char*)(F.ws + WS_P);
    LAS float* red = (LAS float*)(F.lds + RING_OFF); LAS float* ABl = (LAS float*)(F.lds + RING_OFF + 4096);
    const int nb = lat_only ? NB * 128 : NB * 144;
    const bool contig = F.G == 256;
    const int j0 = contig ? (F.vcu * nb) >> 8 : F.vcu, j1 = contig ? ((F.vcu + 1) * nb) >> 8 : nb, jstep = contig ? 1 : F.G;
#define NB_DEC(j_, b_, sb_) do { if (lat_only) { b_ = (j_) >> 7; sb_ = 16 + ((j_) & 127); } else { b_ = (j_) / 144; sb_ = (j_) - b_ * 144; } } while (0)
#define NB_BASE(b_, sb_) (((unsigned)((b_) * 18 + ((sb_) >> 3)) * 32u + 4u * (unsigned)w) * 16384u + (unsigned)((sb_) & 7) * 2048u + loff)
#define NB_IOFF(i_) ((unsigned)((i_) >> 1) * 16384u + (unsigned)((i_) & 1) * 1024u)
    int cur_r = -1, buf = 0;
    xh8_t hn[8]; bool hn_ok = false;
    if (j0 < j1) { int b_, sb_; NB_DEC(j0, b_, sb_); if (!(cin && sb_ < 16)) { const char* xs = Xb + NB_BASE(b_, sb_);
#pragma unroll
            for (int i = 0; i < 8; ++i) hn[i] = *(const xh8_t*)(xs + NB_IOFF(i)); hn_ok = true; } }
    for (int j = j0; j < j1; j += jstep) {
        int b, sb; NB_DEC(j, b, sb);
        const bool isctx = sb < 16; const int r = isctx ? 8 : b;
        const unsigned base = NB_BASE(b, sb);
        f32x4 v[16];
        if (hn_ok) {
#pragma unroll
            for (int i = 0; i < 8; ++i) { const xf8_t t = __builtin_convertvector(hn[i], xf8_t); v[2 * i] = (f32x4){t[0], t[1], t[2], t[3]}; v[2 * i + 1] = (f32x4){t[4], t[5], t[6], t[7]}; }
        } else {
            const float* cs = cin + (size_t)(b * CTXL + sb * 16 + fr) * DM + 256 * w + 8 * fq;
#pragma unroll
            for (int i = 0; i < 8; ++i) { v[2 * i] = *(const f32x4*)(cs + 32 * i); v[2 * i + 1] = *(const f32x4*)(cs + 32 * i + 4); }
        }
        hn_ok = false;
        if (j + jstep < j1) { int b_, sb_; NB_DEC(j + jstep, b_, sb_); if (!(cin && sb_ < 16)) { const char* xs = Xb + NB_BASE(b_, sb_);
#pragma unroll
                for (int i = 0; i < 8; ++i) hn[i] = *(const xh8_t*)(xs + NB_IOFF(i)); hn_ok = true; } }
        if (r != cur_r) { cur_r = r;
            const float* sc = modL + (size_t)r * NMODC + scale_chunk * DM; const float* sh = modL + (size_t)r * NMODC + shift_chunk * DM;
            __syncthreads();
            { const f32x4 g = *(const f32x4*)(gain + tid * 4), s4 = *(const f32x4*)(sc + tid * 4), h4 = *(const f32x4*)(sh + tid * 4);
              *(LAS f32x4*)(ABl + tid * 4) = g * (1.0f + s4); *(LAS f32x4*)(ABl + 2048 + tid * 4) = h4; }
            __syncthreads(); }
        if (pend && isctx) {
            const char* ps = Pb + (((unsigned)(b * 2 + (sb >> 3)) * 32u + 4u * (unsigned)w) * 16384u + (unsigned)(sb & 7) * 2048u + loff);
#pragma unroll
            for (int q = 0; q < 4; ++q)
#pragma unroll
                for (int i = 0; i < 8; ++i) { const xf8_t t = __builtin_convertvector(*(const xh8_t*)(ps + (size_t)q * (2048u * 4096u) + NB_IOFF(i)), xf8_t);
                    v[2 * i] += (f32x4){t[0], t[1], t[2], t[3]}; v[2 * i + 1] += (f32x4){t[4], t[5], t[6], t[7]}; }
#pragma unroll
            for (int i = 0; i < 8; ++i) { const xf8_t t = {v[2 * i][0], v[2 * i][1], v[2 * i][2], v[2 * i][3], v[2 * i + 1][0], v[2 * i + 1][1], v[2 * i + 1][2], v[2 * i + 1][3]};
                *(xh8_t*)(Xb + base + NB_IOFF(i)) = __builtin_convertvector(t, xh8_t); }
        }
        float ss = 0.f;
#pragma unroll
        for (int i = 0; i < 16; ++i) ss += (v[i].x * v[i].x + v[i].y * v[i].y) + (v[i].z * v[i].z + v[i].w * v[i].w);
        ss += __shfl_xor(ss, 16); ss += __shfl_xor(ss, 32);
        if (fq == 0) red[buf * 128 + w * 16 + fr] = ss;
        __syncthreads();
        float tot = 0.f;
#pragma unroll
        for (int k = 0; k < 8; ++k) tot += red[buf * 128 + k * 16 + fr];
        const float rstd = 1.0f / sqrtf(tot * (1.0f / DM) + EPS);
#pragma unroll
        for (int i = 0; i < 8; ++i) { const int c0 = 256 * w + 32 * i + 8 * fq;
            const f32x4 a0 = *(const LAS f32x4*)(ABl + c0), a1 = *(const LAS f32x4*)(ABl + c0 + 4), b0 = *(const LAS f32x4*)(ABl + 2048 + c0), b1 = *(const LAS f32x4*)(ABl + 2048 + c0 + 4);
            const f32x4 y0 = v[2 * i] * rstd * a0 + b0, y1 = v[2 * i + 1] * rstd * a1 + b1;
            v4u o; o.x = pk2(y0.x, y0.y); o.y = pk2(y0.z, y0.w); o.z = pk2(y1.x, y1.y); o.w = pk2(y1.z, y1.w);
            *(v4u*)(XNb + base + NB_IOFF(i)) = o; }
        buf ^= 1;
    }
    __syncthreads();
#undef NB_DEC
#undef NB_BASE
#undef NB_IOFF
}
#endif
__device__ __forceinline__ void final_norm_phase(Frame& F, const float* gain, float* out) {
    FRESH_LANE(lane);
    const int gw = F.vcu * NWAVES + F.wave, NGW = F.G * NWAVES;
    const xres_t* X = (const xres_t*)(F.ws + (XT ? WS_XN : WS_X));
    f32x4 A[8];
#pragma unroll
    for (int j = 0; j < 8; ++j) A[j] = *(const f32x4*)(gain + NCOL(j, lane));
#if XH && NORM16
    xh8_t vn[4];
#define FN_ISSUE(lr_) do { const xres_t* xr = X + (size_t)(((lr_) >> 11) * SROW + CTXL + ((lr_) & 2047)) * DM + lane * 8; _Pragma("unroll") for (int j = 0; j < 4; ++j) vn[j] = *(const xh8_t*)(xr + j * 512); } while (0)
#define FN_TAKE() do { _Pragma("unroll") for (int j = 0; j < 4; ++j) { const xf8_t t = __builtin_convertvector(vn[j], xf8_t); v[2 * j] = (f32x4){t[0], t[1], t[2], t[3]}; v[2 * j + 1] = (f32x4){t[4], t[5], t[6], t[7]}; } } while (0)
#elif XH
    xh4_t vn[8];
#define FN_ISSUE(lr_) do { const xres_t* xr = X + (size_t)(((lr_) >> 11) * SROW + CTXL + ((lr_) & 2047)) * DM + lane * 4; _Pragma("unroll") for (int j = 0; j < 8; ++j) vn[j] = *(const xh4_t*)(xr + j * 256); } while (0)
#define FN_TAKE() do { _Pragma("unroll") for (int j = 0; j < 8; ++j) v[j] = __builtin_convertvector(vn[j], f32x4); } while (0)
#else
    f32x4 vn[8];
#define FN_ISSUE(lr_) do { const xres_t* xr = X + (size_t)(((lr_) >> 11) * SROW + CTXL + ((lr_) & 2047)) * DM; _Pragma("unroll") for (int j = 0; j < 8; ++j) vn[j] = *(const f32x4*)(xr + NCOL(j, lane)); } while (0)
#define FN_TAKE() do { _Pragma("unroll") for (int j = 0; j < 8; ++j) v[j] = vn[j]; } while (0)
#endif
    if (gw < NB * SEQL) FN_ISSUE(gw);
    for (int lr = gw; lr < NB * SEQL; lr += NGW) {
        f32x4 v[8];
        FN_TAKE();
        const int ln = lr + NGW;
        if (ln < NB * SEQL) FN_ISSUE(ln);
        float ss = 0.f;
#pragma unroll
        for (int j = 0; j < 8; ++j) ss += (v[j].x * v[j].x + v[j].y * v[j].y) + (v[j].z * v[j].z + v[j].w * v[j].w);
        const float rstd = 1.0f / sqrtf(wave_sum(ss) * (1.0f / DM) + EPS);
        float* o = out + (size_t)lr * DM;
#pragma unroll
        for (int j = 0; j < 8; ++j) *(f32x4*)(o + NCOL(j, lane)) = v[j] * rstd * A[j];
    }
#undef FN_ISSUE
#undef FN_TAKE
}

#ifndef HYB_SLIDE
#define HYB_SLIDE 0
#endif
__device__ __forceinline__ void hyb_thin(Frame& F, const float* conv_w, const float* k_gain, const int gw, const int NGW, const int part = 3  ) {
    FRESH_LANE(lane); const int tid = F.wave * 64 + lane; (void)tid;

    bf16* U = (bf16*)(F.ws + WS_H); bf16* AO = (bf16*)(F.ws + WS_AO);
    const float* cosA = (const float*)(F.ws + WS_ROPE); const float* sinA = cosA + SEQL * 64;
    const bool blm = BATCH_LOCAL && F.G == 256 && NGW == 2048;
#if HYB_SLIDE
    { const v4u zero = (v4u){0u, 0u, 0u, 0u};
      for (int wi = gw; wi < (MT / 9) * 2; wi += NGW) {
        const int blk = wi >> 1, hf = wi & 1, r0 = blk * 9, c0 = hf * 512 + lane * 8;
        const f32x4 w0a = *(const f32x4*)(conv_w + c0), w0b = *(const f32x4*)(conv_w + c0 + 4);
        const f32x4 w1a = *(const f32x4*)(conv_w + 1024 + c0), w1b = *(const f32x4*)(conv_w + 1024 + c0 + 4);
        const f32x4 w2a = *(const f32x4*)(conv_w + 2048 + c0), w2b = *(const f32x4*)(conv_w + 2048 + c0 + 4);
        const bf16* ub = U + (size_t)r0 * U_LD + c0;
        v4u gP = zero, uP = zero;
        if (r0 > 0) { gP = *(const v4u*)(ub - U_LD + 1024); uP = *(const v4u*)(ub - U_LD + 2048); }
        v4u gC = *(const v4u*)(ub + 1024), uC = *(const v4u*)(ub + 2048), bC = *(const v4u*)ub;
        v4u gN = *(const v4u*)(ub + U_LD + 1024), uN = *(const v4u*)(ub + U_LD + 2048), bN = *(const v4u*)(ub + U_LD);
#pragma unroll
        for (int i = 0; i < 9; ++i) {
            const int row = r0 + i, s = row % SROW;
            v4u gNN = zero, uNN = zero, bNN = zero;
            if (i + 2 < 10 && row + 2 < MT) { const bf16* un = ub + (size_t)(i + 2) * U_LD; gNN = *(const v4u*)(un + 1024); uNN = *(const v4u*)(un + 2048); if (i + 2 < 9) bNN = *(const v4u*)un; }
            const bool has_p = (s != 0 && s != CTXL), has_n = (s != CTXL - 1 && s != SROW - 1);
            float fb[8], fc0[8], fu0[8], fc1[8], fu1[8], fc2[8], fu2[8], y[8];
            unpack8(bC, fb); unpack8(has_p ? gP : zero, fc0); unpack8(has_p ? uP : zero, fu0); unpack8(gC, fc1); unpack8(uC, fu1); unpack8(has_n ? gN : zero, fc2); unpack8(has_n ? uN : zero, fu2);
#pragma unroll
            for (int e = 0; e < 4; ++e) { y[e] = fb[e] * ((fc0[e] * fu0[e]) * w0a[e] + (fc1[e] * fu1[e]) * w1a[e] + (fc2[e] * fu2[e]) * w2a[e]);
                y[4 + e] = fb[4 + e] * ((fc0[4 + e] * fu0[4 + e]) * w0b[e] + (fc1[4 + e] * fu1[4 + e]) * w1b[e] + (fc2[4 + e] * fu2[4 + e]) * w2b[e]); }
            if (AO_IMG) *(v4u*)((char*)AO + pg8::img_off(row, c0, DM)) = pack8(y); else *(v4u*)(AO + (size_t)row * DM + c0) = pack8(y);
            gP = gC; uP = uC; gC = gN; uC = uN; bC = bN; gN = gNN; uN = uNN; bN = bNN;
        }
      }
    }
#else
    if (part & 1) {
    const v4u zero = (v4u){0u, 0u, 0u, 0u};
#define HT_LOAD(it_, GB, GC0, U0, GC1, U1, GC2, U2) do { const int row_ = (it_) >> 1, c0_ = ((it_) & 1) * 512 + lane * 8, s_ = row_ % SROW; \
        const bf16* ur_ = U + (size_t)row_ * U_LD + c0_; GB = *(const v4u*)ur_; GC1 = *(const v4u*)(ur_ + 1024); U1 = *(const v4u*)(ur_ + 2048); \
        GC0 = zero; U0 = zero; GC2 = zero; U2 = zero; \
        if (s_ != 0 && s_ != CTXL) { GC0 = *(const v4u*)(ur_ - U_LD + 1024); U0 = *(const v4u*)(ur_ - U_LD + 2048); } \
        if (s_ != CTXL - 1 && s_ != SROW - 1) { GC2 = *(const v4u*)(ur_ + U_LD + 1024); U2 = *(const v4u*)(ur_ + U_LD + 2048); } } while (0)
    v4u ngb = zero, ngc0 = zero, nu0 = zero, ngc1 = zero, nu1 = zero, ngc2 = zero, nu2 = zero;
    { const int it0_ = blm ? gw * 18 : gw; if (it0_ < MT * 2) HT_LOAD(it0_, ngb, ngc0, nu0, ngc1, nu1, ngc2, nu2); }
    for (int n_ = 0; n_ < (MT * 2 + NGW - 1) / NGW; ++n_) {
        const int it = blm ? gw * 18 + n_ : gw + n_ * NGW; if (it >= MT * 2) break;
        const int row = it >> 1, c0 = (it & 1) * 512 + lane * 8;
        const v4u gb = ngb, gc0 = ngc0, u0 = nu0, gc1 = ngc1, u1 = nu1, gc2 = ngc2, u2 = nu2;
        { const int itn = blm ? gw * 18 + n_ + 1 : gw + (n_ + 1) * NGW; if (n_ + 1 < (MT * 2 + NGW - 1) / NGW && itn < MT * 2) HT_LOAD(itn, ngb, ngc0, nu0, ngc1, nu1, ngc2, nu2); }
        float fb[8], fc0[8], fu0[8], fc1[8], fu1[8], fc2[8], fu2[8], y[8];
        unpack8(gb, fb); unpack8(gc0, fc0); unpack8(u0, fu0); unpack8(gc1, fc1); unpack8(u1, fu1); unpack8(gc2, fc2); unpack8(u2, fu2);
        const f32x4 w0a = *(const f32x4*)(conv_w + c0), w0b = *(const f32x4*)(conv_w + c0 + 4);
        const f32x4 w1a = *(const f32x4*)(conv_w + 1024 + c0), w1b = *(const f32x4*)(conv_w + 1024 + c0 + 4);
        const f32x4 w2a = *(const f32x4*)(conv_w + 2048 + c0), w2b = *(const f32x4*)(conv_w + 2048 + c0 + 4);
#pragma unroll
        for (int e = 0; e < 4; ++e) { y[e] = fb[e] * ((fc0[e] * fu0[e]) * w0a[e] + (fc1[e] * fu1[e]) * w1a[e] + (fc2[e] * fu2[e]) * w2a[e]);
            y[4 + e] = fb[4 + e] * ((fc0[4 + e] * fu0[4 + e]) * w0b[e] + (fc1[4 + e] * fu1[4 + e]) * w1b[e] + (fc2[4 + e] * fu2[4 + e]) * w2b[e]); }
        if (AO_IMG) *(v4u*)((char*)AO + pg8::img_off(row, c0, DM)) = pack8(y); else *(v4u*)(AO + (size_t)row * DM + c0) = pack8(y);
    }
#undef HT_LOAD
    }
#endif
    if (part & 2) {
    v4u kraw[5];
#pragma unroll
    for (int n_ = 0; n_ < 5; ++n_) {
        const int sub = lane >> 4, ch = lane & 15, g = sub & 1;
        int row; bool okr;
        if (blm) { row = gw * 9 + n_ * 2 + (sub >> 1); okr = (n_ * 2 + (sub >> 1)) < 9; }
        else { const int it = gw + n_ * NGW; row = it * 2 + (sub >> 1); okr = it < MT / 2; }
        if (!okr) row = gw * 9;
        kraw[n_] = *(const v4u*)(U + (size_t)row * U_LD + 4096 + g * 128 + ch * 8); }
#pragma unroll
    for (int n_ = 0; n_ < 5; ++n_) {
        const int sub = lane >> 4, ch = lane & 15, g = sub & 1;
        int row; bool okr;
        if (blm) { row = gw * 9 + n_ * 2 + (sub >> 1); okr = (n_ * 2 + (sub >> 1)) < 9; }
        else { const int it = gw + n_ * NGW; row = it * 2 + (sub >> 1); okr = it < MT / 2; }
        if (!okr) row = gw * 9;
        const int s = row % SROW;
        bf16* kp = U + (size_t)row * U_LD + 4096 + g * 128 + ch * 8;
        float y[8]; unpack8(kraw[n_], y);
        float ss = 0.f;
#pragma unroll
        for (int e = 0; e < 8; ++e) ss += y[e] * y[e];
        ss += __shfl_xor(ss, 1); ss += __shfl_xor(ss, 2); ss += __shfl_xor(ss, 4); ss += __shfl_xor(ss, 8);
        const float rstd = 1.0f / sqrtf(ss * (1.0f / 128.0f) + EPS);
        const f32x4 g0 = *(const f32x4*)(k_gain + ch * 8), g1 = *(const f32x4*)(k_gain + ch * 8 + 4);
#pragma unroll
        for (int e = 0; e < 4; ++e) { y[e] = y[e] * rstd * g0[e]; y[4 + e] = y[4 + e] * rstd * g1[e]; }
        if (s >= CTXL) { const int t = s - CTXL; const f32x4 c = *(const f32x4*)(cosA + t * 64 + ch * 4), sn = *(const f32x4*)(sinA + t * 64 + ch * 4);
#pragma unroll
            for (int p = 0; p < 4; ++p) { const float x0 = y[2 * p], x1 = y[2 * p + 1]; y[2 * p] = x0 * c[p] - x1 * sn[p]; y[2 * p + 1] = x0 * sn[p] + x1 * c[p]; } }
        if (okr) *(v4u*)kp = pack8(y);
    }
    }
}

__device__ __forceinline__ void mla_thin(Frame& F, const float* q_gain, const float* kv_gain) {
    FRESH_LANE(lane); const int tid = F.wave * 64 + lane; (void)tid;
    const int gw = F.vcu * NWAVES + F.wave, NGW = F.G * NWAVES;
    bf16* CD = BATCH_LOCAL ? (bf16*)(F.ws + WS_H) + MLA_KVW : (bf16*)(F.ws + WS_CD);
    const float* cosM = (const float*)(F.ws + WS_ROPE) + 2 * SEQL * 64; const float* sinM = cosM + SEQL * 32;
    const bool blm = BATCH_LOCAL && F.G == 256;
    const v4u zero = (v4u){0u, 0u, 0u, 0u};
#define MT_LOAD(row_, A0, A1, KV, KR) do { const bf16* c_ = CD + (size_t)(row_) * CD_LD; A0 = *(const v4u*)(c_ + lane * 8); A1 = lane < 32 ? *(const v4u*)(c_ + 512 + lane * 8) : zero; \
        KV = *(const v4u*)(c_ + 768 + lane * 8); KR = lane < 8 ? *(const v4u*)(c_ + 1280 + lane * 8) : zero; } while (0)
    v4u na0 = zero, na1 = zero, nkv = zero, nkr = zero;
    { const int row0_ = blm ? gw * 9 : gw; if (row0_ < MT) MT_LOAD(row0_, na0, na1, nkv, nkr); }
    for (int n_ = 0; n_ < (MT + NGW - 1) / NGW; ++n_) {
        const int row = blm ? gw * 9 + n_ : gw + n_ * NGW; if (row >= MT) break;
        bf16* cd = CD + (size_t)row * CD_LD; const int s = row % SROW;
        const v4u a0 = na0, a1 = na1, kv = nkv, kr = nkr;
        { const int rown = blm ? gw * 9 + n_ + 1 : gw + (n_ + 1) * NGW; if (n_ + 1 < (MT + NGW - 1) / NGW && rown < MT) MT_LOAD(rown, na0, na1, nkv, nkr); }
        float y0[8], y1[8], yk[8]; unpack8(a0, y0); unpack8(a1, y1); unpack8(kv, yk);
        float sq = 0.f, sk = 0.f;
#pragma unroll
        for (int e = 0; e < 8; ++e) { sq += y0[e] * y0[e] + y1[e] * y1[e]; sk += yk[e] * yk[e]; }
        const float rq = 1.0f / sqrtf(wave_sum(sq) * (1.0f / 768.0f) + EPS), rk = 1.0f / sqrtf(wave_sum(sk) * (1.0f / 512.0f) + EPS);
        { const f32x4 g0 = *(const f32x4*)(q_gain + lane * 8), g1 = *(const f32x4*)(q_gain + lane * 8 + 4);
#pragma unroll
          for (int e = 0; e < 4; ++e) { y0[e] = y0[e] * rq * g0[e]; y0[4 + e] = y0[4 + e] * rq * g1[e]; }
          *(v4u*)(cd + lane * 8) = pack8(y0); }
        if (lane < 32) { const f32x4 g0 = *(const f32x4*)(q_gain + 512 + lane * 8), g1 = *(const f32x4*)(q_gain + 512 + lane * 8 + 4);
#pragma unroll
          for (int e = 0; e < 4; ++e) { y1[e] = y1[e] * rq * g0[e]; y1[4 + e] = y1[4 + e] * rq * g1[e]; }
          *(v4u*)(cd + 512 + lane * 8) = pack8(y1); }
        { const f32x4 g0 = *(const f32x4*)(kv_gain + lane * 8), g1 = *(const f32x4*)(kv_gain + lane * 8 + 4);
#pragma unroll
          for (int e = 0; e < 4; ++e) { yk[e] = yk[e] * rk * g0[e]; yk[4 + e] = yk[4 + e] * rk * g1[e]; }
          *(v4u*)(cd + 768 + lane * 8) = pack8(yk); }
        if (lane < 8 && s >= CTXL) { const int t = s - CTXL; float yr[8]; unpack8(kr, yr);
            const f32x4 c = *(const f32x4*)(cosM + t * 32 + lane * 4), sn = *(const f32x4*)(sinM + t * 32 + lane * 4);
#pragma unroll
            for (int p = 0; p < 4; ++p) { const float x0 = yr[2 * p], x1 = yr[2 * p + 1]; yr[2 * p] = x0 * c[p] - x1 * sn[p]; yr[2 * p + 1] = x0 * sn[p] + x1 * c[p]; }
            *(v4u*)(cd + 1280 + lane * 8) = pack8(yr); }
    }
#undef MT_LOAD
}

#ifndef GU_SKEW_US
#define GU_SKEW_US 0
#endif
__device__ __forceinline__ void skew_start(int nwg, int G, int c, int max_us) {
    if (max_us <= 0) return;
    const int rem = nwg % G;
    if (rem == 0 || c < rem) return;
    const unsigned ticks = (unsigned)(((long)(c - rem) * max_us * 100) / (G - rem));
    const unsigned long long t0 = __builtin_amdgcn_s_memrealtime();
    while ((unsigned)(__builtin_amdgcn_s_memrealtime() - t0) < ticks) __builtin_amdgcn_s_sleep(16);
}
__global__ void __launch_bounds__(NWAVES * 64, 2) mk_fwd(Args args) {
    extern __shared__ __attribute__((aligned(16))) unsigned char lds_raw[];
    Frame F;
    F.lds = (LAS unsigned char*)lds_raw;
    F.MISC = (volatile LAS unsigned*)(F.lds + MISC_OFF);
    F.wave = __builtin_amdgcn_readfirstlane((int)threadIdx.x >> 6);
    F.G = gridDim.x; { const int bx = blockIdx.x; F.vcu = (F.G % 8 == 0) ? (bx % 8) * (F.G / 8) + bx / 8 : bx; }
    F.ws = args.ws;
    unsigned char* ws = args.ws;
    { FRESH_LANE(l0); for (int u = F.wave * 64 + l0; u < (LDS_BYTES - LDSCTL_OFF) / 4; u += NWAVES * 64) ((LAS unsigned*)(F.lds + LDSCTL_OFF))[u] = 0u; }
    __syncthreads();
    XcdBarrier bar; bar.bar = (unsigned*)(ws + WS_CTL) + CW_BAR; bar.x = 0; bar.st = nullptr;
    if (!MK_PER_PHASE) { FRESH_LANE(l1); bar = xcd_barrier_post((unsigned*)(ws + WS_CTL) + CW_BAR, F.MISC + 8, F.wave == 0 && l1 == 0); }
    const int lo = args.ph_lo, hi = args.ph_hi;
    int pid = 0;
#define IN_PH() (lo <= pid && pid < hi)
#ifndef CONV_IN_ATT
#define CONV_IN_ATT 0
#endif
#ifndef MLA_SDEPTH
#define MLA_SDEPTH 1
#endif
#ifndef NORM_RM_PROBE
#define NORM_RM_PROBE 0
#endif
#ifndef MLA_WGM
#define MLA_WGM 8
#endif
#ifndef HIN_WGM
#define HIN_WGM 8
#endif
#ifndef OUT_WGM
#define OUT_WGM 4
#endif
#ifndef REPMASK
#define REPMASK 0
#endif
#define NREP(bit) (((REPMASK >> (bit)) & 1) ? 2 : 1)
#define REPBAR(bit, it) do { if (((REPMASK >> (bit)) & 1) && (it) == 0) { FRESH_LANE(lr_); xcd_barrier(bar, F.wave == 0 && lr_ == 0); } } while (0)
    const bool BL = BATCH_LOCAL && F.G == 256;
#ifndef PROBE_BAR
#define PROBE_BAR 0
#endif
#define SEAM() do { if (lo <= pid && pid + 1 < hi) { FRESH_LANE(lb_); if (BL && pid >= 2) xcd_barrier_local(bar, F.wave == 0 && lb_ == 0); else xcd_barrier(bar, F.wave == 0 && lb_ == 0); \
        } ++pid; } while (0)

    bf16* XN = (bf16*)(ws + WS_XN); bf16* AO = (bf16*)(ws + WS_AO); bf16* HB = (bf16*)(ws + WS_H); xres_t* X = (xres_t*)(ws + WS_X); float* MODV = (float*)(ws + WS_MODV);
    const int bid = (int)blockIdx.x;

    if (IN_PH()) for (int rep = 0; rep < NREP(0); ++rep) { p0_prologue(F, args); REPBAR(0, rep); }
    SEAM();
#if PROBE_BAR
    { FRESH_LANE(lq_); for (int pb_ = 0; pb_ < PROBE_BAR; ++pb_) xcd_barrier(bar, F.wave == 0 && lq_ == 0); }
#endif
    if (IN_PH()) { FRESH_LANE(l2_); mod_gemv_reduce(F, args, 0, (F.vcu * NWAVES + F.wave) * 64 + l2_, F.G * NWAVES * 64); mod_gemv_reduce(F, args, 1, (F.vcu * NWAVES + F.wave) * 64 + l2_, F.G * NWAVES * 64); }
    SEAM();

#pragma unroll 1
    for (int layer = 0; layer < 2; ++layer) {
        const float* modL = MODV + (size_t)layer * 9 * NMODC;
#pragma unroll 1
        for (int f = 0; f < 2; ++f) {
            const bool lat_only = (layer == 1 && f == 1);
            const int nMv = lat_only ? 64 : 72, mmode = lat_only ? 1 : 0;
            if (IN_PH()) for (int rep = 0; rep < NREP(4); ++rep) {
#if XT
                if (layer == 0 && f == 0) norm_phase(F, args.in[6], modL, 0, 1, false, false, args.in[0], args.in[2]);
                else norm_band_phase(F, args.in[f == 0 ? 6 : 8] + layer * DM, modL, f * 6 + 0, f * 6 + 1, lat_only, (layer + f) == 1, nullptr);
#else
#if XH && NORM16 && NORM_D2
                if (layer == 0 && f == 0) norm_phase(F, args.in[6], modL, 0, 1, false, false, args.in[0], args.in[2]);
                else norm_phase_d2(F, args.in[f == 0 ? 6 : 8] + layer * DM, modL, f * 6 + 0, f * 6 + 1, lat_only, (layer + f) == 1, nullptr);
#else
                norm_phase(F, args.in[f == 0 ? 6 : 8] + layer * DM, modL, f * 6 + 0, f * 6 + 1, lat_only, (layer + f) == 1 && !(NORM_RM_PROBE && rep == 0 && NREP(4) == 2), (layer == 0 && f == 0) ? args.in[0] : nullptr, (layer == 0 && f == 0) ? args.in[2] : nullptr, NORM_RM_PROBE && rep == 0 && NREP(4) == 2);
#endif
#endif
                REPBAR(4, rep); }
            SEAM();
            if (IN_PH()) for (int rep = 0; rep < NREP(1); ++rep) {
                REPBAR(1, rep ^ 1);
                pg8::Gemm g{XN, (const bf16*)(ws + WS_WGU + (size_t)(layer * 2 + f) * SZ_WGU), DM, DM, DM / 64};
#ifndef GU_WGM
#define GU_WGM 8
#endif
#ifdef PROBE_HALF
                if (layer == 0 && f == 0) {
                    const int grp = (bid >> 3) & 1, rk = ((bid >> 4) << 3) | (bid & 7);
                    if (grp == 0) { pg8::Sched S; S.init(nMv, 2 * DFF / 256, 1, 0, mmode, F.G / 2, rk, GU_WGM);
                        pg8::EpiSwiGLU<IMG_H> E{HB, DFF};
                        pg8::gemm_phase<pg8::EpiSwiGLU<IMG_H>, IMG_H, IMG_H>(F.lds + RING_OFF, g, S, E, F.wave); }
#if PROBE_HALF == 2
                    else { FRESH_LANE(ls_); const int gw2 = rk * NWAVES + F.wave, NGW2 = (F.G / 2) * NWAVES;
                        const float* Xs = (const float*)(ws + WS_X); float* Os = (float*)(ws + WS_TOTAL + 16 * MiB);
                        for (int rep_ = 0; rep_ < 10; ++rep_)
                            for (int lr = gw2; lr < MT; lr += NGW2) { const f32x4* xr = (const f32x4*)(Xs + (size_t)lr * DM) + ls_; f32x4 v_[8]; f32x4 acc_ = (f32x4){0.f, 0.f, 0.f, 0.f};
#pragma unroll
                                for (int j = 0; j < 8; ++j) v_[j] = xr[64 * j];
#pragma unroll
                                for (int j = 0; j < 8; ++j) acc_ += v_[j];
                                f32x4* o_ = (f32x4*)(Os + (size_t)lr * (DM / 2)) + ls_;
#pragma unroll
                                for (int j = 0; j < 4; ++j) o_[64 * j] = acc_ * (float)(j + rep_); } }
#endif
                } else
#endif
                {
                pg8::Sched S; S.init(nMv, 2 * DFF / 256, 1, 0, mmode, F.G, bid, GU_WGM);
                skew_start(S.nwg, F.G, bid, GU_SKEW_US);
#ifdef PROBE_GU
                if (rep == 0 && NREP(1) == 2) { pg8::EpiNull E{}; pg8::gemm_phase<pg8::EpiNull, IMG_H, IMG_H>(F.lds + RING_OFF, g, S, E, F.wave); } else
#endif
                { pg8::EpiSwiGLU<IMG_H> E{HB, DFF};
                pg8::gemm_phase<pg8::EpiSwiGLU<IMG_H>, IMG_H, IMG_H>(F.lds + RING_OFF, g, S, E, F.wave); }
                }
            }
            SEAM();
            if (IN_PH()) {
                const bf16* Wd = (const bf16*)(ws + WS_WD + (size_t)(layer * 2 + f) * SZ_WD);
#ifndef DOWN_WGM
#define DOWN_WGM 4
#endif
                { pg8::Gemm g{HB, Wd, DFF, DFF, DFF / 64};
                  pg8::Sched S; S.init(64, DM / 256, 1, 0, 1, F.G, bid, DOWN_WGM);
                  pg8::EpiResid<true, false> E{X, modL + (f * 6 + 2) * DM, nullptr, (layer == 0 && f == 0) ? args.in[0] : nullptr, args.in[2], (XT && layer == 1 && f == 1) ? (xres_t*)(ws + WS_XN) : nullptr};
                  pg8::gemm_phase<pg8::EpiResid<true, false>, IMG_H, IMG_H, DOWN_KREV>(F.lds + RING_OFF, g, S, E, F.wave); }
#ifdef PROBE_DOWN
                { FRESH_LANE(lp_); xcd_barrier(bar, F.wave == 0 && lp_ == 0); }
#if PROBE_DOWN == 2
                { pg8::Gemm g{HB, Wd, DFF, DFF, DFF / 64};
                  pg8::Sched S; S.init(64, DM / 256, 1, 0, 1, F.G, bid);
                  pg8::EpiResid<true, false> E{(xres_t*)(ws + WS_TOTAL + 16 * MiB), modL + (f * 6 + 2) * DM, nullptr, nullptr, nullptr, nullptr};
                  pg8::gemm_phase<pg8::EpiResid<true, false>, IMG_H, IMG_H>(F.lds + RING_OFF, g, S, E, F.wave); }
#elif PROBE_DOWN == 5
                { pg8::Gemm g{HB, Wd, DFF, DFF, DFF / 64};
                  pg8::Sched S; S.init(64, DM / 256, 1, 0, 1, F.G, bid);
                  pg8::EpiStoreImg E{(bf16*)(ws + WS_END), DM};
                  pg8::gemm_phase<pg8::EpiStoreImg, IMG_H, IMG_H>(F.lds + RING_OFF, g, S, E, F.wave); }
#elif PROBE_DOWN == 6
                { pg8::Gemm g{HB, Wd, DFF, DFF, DFF / 64};
                  pg8::Sched S; S.init(64, DM / 256, 1, 0, 1, F.G, bid);
                  pg8::EpiStoreSwap E{(bf16*)(ws + WS_END), DM};
                  pg8::gemm_phase<pg8::EpiStoreSwap, IMG_H, IMG_H>(F.lds + RING_OFF, g, S, E, F.wave); }
#elif PROBE_DOWN == 4
                { pg8::Gemm g{HB, Wd, DFF, DFF, DFF / 64};
                  pg8::Sched S; S.init(64, DM / 256, 1, 0, 1, F.G, bid);
                  pg8::EpiNull E{};
                  pg8::gemm_phase<pg8::EpiNull, IMG_H, IMG_H>(F.lds + RING_OFF, g, S, E, F.wave); }
#else
                { pg8::Gemm g{HB, Wd, DFF, DFF, DFF / 64};
                  pg8::Sched S; S.init(64, DM / 256, 1, 0, 1, F.G, bid); S.probe_alias = (PROBE_DOWN == 3);
                  pg8::EpiStore E{(bf16*)(ws + WS_END), DM};
                  pg8::gemm_phase<pg8::EpiStore, IMG_H, IMG_H>(F.lds + RING_OFF, g, S, E, F.wave); }
#endif
#endif
                if (!lat_only) {
                  pg8::Gemm g{HB, Wd, DFF, DFF, DFF / 64 / 4};
                  pg8::Sched S; S.init(8, DM / 256, 4, DFF / 4, 2, F.G, bid);
                  pg8::EpiResid<true, true> E{X, modL + (f * 6 + 2) * DM, (float*)(ws + WS_P), nullptr, nullptr, nullptr};
                  pg8::gemm_phase<pg8::EpiResid<true, true>, IMG_H, IMG_H, DOWN_KREV>(F.lds + RING_OFF, g, S, E, F.wave); }
            }
            SEAM();
            if (f == 0) {
                if (IN_PH()) for (int rep = 0; rep < NREP(4); ++rep) {
#if XT
                    norm_band_phase(F, args.in[7] + layer * DM, modL, 3, 4, false, true, layer == 0 ? args.in[2] : nullptr);
#else
#if XH && NORM16 && NORM_D2
                    norm_phase_d2(F, args.in[7] + layer * DM, modL, 3, 4, false, true, layer == 0 ? args.in[2] : nullptr);
#else
                    norm_phase(F, args.in[7] + layer * DM, modL, 3, 4, false, true, nullptr, layer == 0 ? args.in[2] : nullptr);
#endif
#endif
                    REPBAR(4, rep); }
                SEAM();
                if (layer == 0) {
#if HIN_DEFER
                    if (IN_PH()) for (int rp5 = 0; rp5 < NREP(5); ++rp5) { REPBAR(5, rp5 ^ 1);
                        pg8::Gemm g{XN, (const bf16*)(ws + WS_WHIN), DM, DM, DM / 64};
                        pg8::EpiStore E{HB, U_LD};
                        const int nmain = 72 * 17, nb_ = nmain % F.G, nfill = (nb_ == 0) ? 0 : ((F.G - nb_) < 72 ? (F.G - nb_) : 72);
                        { pg8::Sched S; S.init(72, 17, 1, 0, 0, F.G, bid);
                          pg8::gemm_phase<pg8::EpiStore, IMG_H, IMG_H>(F.lds + RING_OFF, g, S, E, F.wave); }
                        if (nfill > 0 && bid >= nb_) { pg8::Sched S; S.init(nfill, 1, 1, 0, 0, nfill, bid - nb_, pg8::WGM, 0, 17);
                          pg8::gemm_phase<pg8::EpiStore, IMG_H, IMG_H>(F.lds + RING_OFF, g, S, E, F.wave); }
                    }
                    SEAM();
                    if (IN_PH()) {
                        const int nmain = 72 * 17, nb_ = nmain % F.G, nfill = (nb_ == 0) ? 0 : ((F.G - nb_) < 72 ? (F.G - nb_) : 72), nrest = 72 - nfill;
                        const int ngemm = nrest < F.G / 2 ? nrest : 0;
                        if (bid < ngemm) { pg8::Gemm g{XN, (const bf16*)(ws + WS_WHIN), DM, DM, DM / 64}; pg8::EpiStore E{HB, U_LD};
                            pg8::Sched S; S.init(nrest, 1, 1, 0, 0, ngemm, bid, pg8::WGM, nfill, 17);
                            pg8::gemm_phase<pg8::EpiStore, IMG_H, IMG_H>(F.lds + RING_OFF, g, S, E, F.wave); }
                        else { if (ngemm == 0 && nrest > 0) { pg8::Gemm g{XN, (const bf16*)(ws + WS_WHIN), DM, DM, DM / 64}; pg8::EpiStore E{HB, U_LD};
                                   pg8::Sched S; S.init(nrest, 1, 1, 0, 0, F.G, bid, pg8::WGM, nfill, 17);
                                   pg8::gemm_phase<pg8::EpiStore, IMG_H, IMG_H>(F.lds + RING_OFF, g, S, E, F.wave); }
                               hyb_thin(F, args.in[16], args.in[18], (bid - ngemm) * NWAVES + F.wave, (F.G - ngemm) * NWAVES); }
                    }
                    SEAM();
#else
                    if (IN_PH()) for (int rp5 = 0; rp5 < NREP(5); ++rp5) { REPBAR(5, rp5 ^ 1);
                        pg8::Gemm g{XN, (const bf16*)(ws + WS_WHIN), DM, DM, DM / 64};
                        pg8::Sched S; S.init(72, HYB_IN / 256, 1, 0, 0, F.G, bid, HIN_WGM);
                        pg8::EpiStore E{HB, U_LD};
                        pg8::gemm_phase<pg8::EpiStore, IMG_H, IMG_H>(F.lds + RING_OFF, g, S, E, F.wave);
                    }
                    SEAM();
                    if (IN_PH()) hyb_thin(F, args.in[16], args.in[18], F.vcu * NWAVES + F.wave, F.G * NWAVES, CONV_IN_ATT ? 2 : 3);
                    SEAM();
#endif
                    if (IN_PH()) {
                        const float* cosA = (const float*)(ws + WS_ROPE); const float* sinA = cosA + SEQL * 64;
                        for (int rep = 0; rep < NREP(2); ++rep) { REPBAR(2, rep ^ 1);
                        for (int L = BL ? (bid >> 3) : bid; L < (BL ? 72 : 512 + 64); L += (BL ? (F.G >> 3) : F.G)) {
                            att::AttnArgs a;
                            int b, hq, row0;
                            if (BL) { b = bid & 7;
                                if (L < 64) { hq = L >> 3; const int qb = L & 7; row0 = b * SROW + CTXL + qb * 256; a.seq = SROW; a.t0 = qb * 256; }
                                else { hq = L - 64; row0 = b * SROW; a.seq = CTXL; a.t0 = -1; } }
                            else
                            if (L < 512) { const int s_ = (L & 255) >> 3, pair = (L >> 8) * 8 + (L & 7), qb = s_ & 7; b = pair >> 1; hq = (pair & 1) * 4 + (s_ >> 3); row0 = b * SROW + CTXL + qb * 256; a.seq = SROW; a.t0 = qb * 256; }
                            else { const int l2 = L - 512; b = l2 >> 3; hq = l2 & 7; row0 = b * SROW; a.seq = CTXL; a.t0 = -1; }
                            const int g = hq >> 2;
                            a.Q = HB + (size_t)row0 * U_LD + 3072 + hq * 128; a.K = HB + (size_t)(b * SROW) * U_LD + 4096 + g * 128; a.KR = nullptr; a.V = HB + (size_t)(b * SROW) * U_LD + 4352 + g * 128;
                            a.O = AO_IMG ? AO : AO + (size_t)row0 * DM + 1024 + hq * 128; a.orow0 = row0; a.ocol0 = 1024 + hq * 128;
                            a.ldq = U_LD; a.ldk = U_LD; a.ldkr = 0; a.ldv = U_LD; a.ldo = DM; a.cosT = cosA; a.sinT = sinA; a.qgain = args.in[17];
                            if (ATT_DMA) att::attn_unit_dma<0, ATT_STAG>(a, F.lds + RING_OFF, F.wave); else att::attn_unit<0, 2>(a, F.lds + RING_OFF, F.wave);
                        }
#if CONV_IN_ATT
                        { const int nshort = (512 + 64) % F.G;
                          if (!BL && nshort > 0 && nshort < F.G) { if (bid >= nshort) hyb_thin(F, args.in[16], args.in[18], (bid - nshort) * NWAVES + F.wave, (F.G - nshort) * NWAVES, 1); }
                          else hyb_thin(F, args.in[16], args.in[18], F.vcu * NWAVES + F.wave, F.G * NWAVES, 1); }
#endif
                        }
                    }
                    SEAM();
                    if (IN_PH()) {
                        { pg8::Gemm g{AO, (const bf16*)(ws + WS_WHOUT), DM, DM, DM / 64};
                          pg8::Sched S; S.init(64, DM / 256, 1, 0, 1, F.G, bid, OUT_WGM);
                          pg8::EpiResid<false, false> E{X, modL + 5 * DM, nullptr, nullptr, nullptr, nullptr};
                          pg8::gemm_phase<pg8::EpiResid<false, false>, AO_IMG != 0, IMG_H>(F.lds + RING_OFF, g, S, E, F.wave); }
                        { pg8::Gemm g{AO, (const bf16*)(ws + WS_WHOUT), DM, DM, DM / 64 / 4};
                          pg8::Sched S; S.init(8, DM / 256, 4, DM / 4, 2, F.G, bid);
                          pg8::EpiResid<false, true> E{X, modL + 5 * DM, (float*)(ws + WS_P), nullptr, nullptr, nullptr};
                          pg8::gemm_phase<pg8::EpiResid<false, true>, AO_IMG != 0, IMG_H>(F.lds + RING_OFF, g, S, E, F.wave); }
                    }
                    SEAM();
                } else {
                    bf16* KV = HB; bf16* CD = BATCH_LOCAL ? HB + MLA_KVW : (bf16*)(ws + WS_CD); bf16* Q2 = (bf16*)(ws + WS_Q2);
                    if (IN_PH()) for (int rp6 = 0; rp6 < NREP(6); ++rp6) { REPBAR(6, rp6 ^ 1);
                        pg8::Gemm g{XN, (const bf16*)(ws + WS_WMDOWN), DM, DM, DM / 64};
                        pg8::Sched S; S.init(72, MLA_DP / 256, 1, 0, 0, F.G, bid, MLA_WGM);
                        pg8::EpiStore E{CD, CD_LD};
                        pg8::gemm_phase<pg8::EpiStore, IMG_H, IMG_H>(F.lds + RING_OFF, g, S, E, F.wave);
                    }
                    SEAM();
                    if (IN_PH()) mla_thin(F, args.in[21], args.in[22]);
                    SEAM();
                    if (IN_PH()) for (int rp7 = 0; rp7 < NREP(7); ++rp7) { REPBAR(7, rp7 ^ 1);
                        { pg8::Gemm g{CD, (const bf16*)(ws + WS_WMUQ), CD_LD, 768, 768 / 64};
                          pg8::Sched S; S.init(64, MLA_QW / 256, 1, 0, 1, F.G, bid, MLA_WGM);
#if Q2_IMG
                          pg8::EpiStoreImg E{Q2, MLA_QW};
                          pg8::gemm_phase<pg8::EpiStoreImg, false, IMG_H>(F.lds + RING_OFF, g, S, E, F.wave); }
#else
                          pg8::EpiStore E{Q2, MLA_QW};
                          pg8::gemm_phase<pg8::EpiStore, false, IMG_H>(F.lds + RING_OFF, g, S, E, F.wave); }
#endif
                        { pg8::Gemm g{CD + 768, (const bf16*)(ws + WS_WMUKV), CD_LD, 512, 512 / 64};
                          pg8::Sched S; S.init(72, MLA_KVW / 256, 1, 0, 0, F.G, bid, MLA_WGM);
                          pg8::EpiStore E{KV, KV_LD};
                          pg8::gemm_phase<pg8::EpiStore, false, IMG_H>(F.lds + RING_OFF, g, S, E, F.wave);
                          }
                    }
                    SEAM();
                    if (IN_PH()) {
                        const float* cosM = (const float*)(ws + WS_ROPE) + 2 * SEQL * 64; const float* sinM = cosM + SEQL * 32;
                        for (int rep = 0; rep < NREP(3); ++rep) { REPBAR(3, rep ^ 1);
                        for (int L0_ = BL ? (bid >> 3) : bid; L0_ < (BL ? 128 : 1024); L0_ += (BL ? (F.G >> 3) : F.G)) {
                            att::AttnArgs a;
                            const int L = L0_, s_ = (L & 255) >> 3, pair = (L >> 8) * 32 + (L & 7) * 4 + (s_ >> 3);
                            const int qb = BL ? (L & 7) : (s_ & 7), b = BL ? (bid & 7) : (pair >> 4), h = BL ? (L >> 3) : (pair & 15), row0 = b * SROW + CTXL + qb * 256;
                            a.Q = Q2_IMG ? Q2 : Q2 + (size_t)row0 * MLA_QW + h * 192; a.qcol0 = h * 192; a.K = KV + (size_t)(b * SROW) * KV_LD + h * 256; a.KR = CD + (size_t)(b * SROW) * CD_LD + 1280; a.V = KV + (size_t)(b * SROW) * KV_LD + h * 256 + 128;
                            a.O = AO_IMG ? AO : AO + (size_t)row0 * DM + h * 128; a.orow0 = row0; a.ocol0 = h * 128;
                            a.ldq = MLA_QW; a.ldk = KV_LD; a.ldkr = CD_LD; a.ldv = KV_LD; a.ldo = DM; a.seq = SROW; a.t0 = qb * 256; a.cosT = cosM; a.sinT = sinM; a.qgain = nullptr;
#ifdef PROBE_MLA0
                            if (rep == 0 && NREP(3) == 2) { a.O = (bf16*)(ws + WS_TOTAL + 16 * MiB) + (size_t)row0 * DM + h * 128; a.cosT = (const float*)(ws + WS_ROPE); a.sinT = a.cosT + SEQL * 64; a.qgain = args.in[17];
                                att::attn_unit<0, 2>(a, F.lds + RING_OFF, F.wave); } else
#endif
                            if (ATT_DMA) att::attn_unit_dma<1, ATT_STAG>(a, F.lds + RING_OFF, F.wave); else att::attn_unit<1, MLA_SDEPTH>(a, F.lds + RING_OFF, F.wave);
                        } }
                    }
                    SEAM();
                    if (IN_PH()) {
                        pg8::Gemm g{AO, (const bf16*)(ws + WS_WMO), DM, DM, DM / 64};
                        pg8::Sched S; S.init(64, DM / 256, 1, 0, 1, F.G, bid, OUT_WGM);
                        pg8::EpiResid<false, false> E{X, modL + 5 * DM, nullptr, nullptr, nullptr, nullptr};
                        pg8::gemm_phase<pg8::EpiResid<false, false>, AO_IMG != 0, IMG_H>(F.lds + RING_OFF, g, S, E, F.wave);
                    }
                    SEAM();
                }
            }
        }
    }
    if (IN_PH()) for (int rep = 0; rep < NREP(4); ++rep) { final_norm_phase(F, args.in[26], args.out); REPBAR(4, rep); }
#undef IN_PH
#undef SEAM
}
constexpr int N_PHASES = 2 + (3 + 1 + 4 + 3) + (3 + 1 + 5 + 3) + 1;

extern "C" void kernel_launch(void* const* d_in, const int* in_sizes, int n_in, void* d_out, int out_size, void* d_ws, size_t ws_size, hipStream_t stream) {
    static int grid = 0;
    if (grid == 0) {
        if (n_in != 27 || in_sizes[0] != NB * SEQL * DM || out_size != NB * SEQL * DM || ws_size < WS_TOTAL) {
            fprintf(stderr, "kernel_launch: shape mismatch: n_in %d in0 %d out %d ws %zu (need %zu); nothing launched\n", n_in, n_in > 0 ? in_sizes[0] : -1, out_size, ws_size, (size_t)WS_END); grid = -1; return; }
        int dev = 0, cus = 0;
        if (hipGetDevice(&dev) != hipSuccess || hipDeviceGetAttribute(&cus, hipDeviceAttributeMultiprocessorCount, dev) != hipSuccess) { fprintf(stderr, "kernel_launch: device query failed\n"); grid = -1; return; }
        if (hipFuncSetAttribute((const void*)mk_fwd, hipFuncAttributeMaxDynamicSharedMemorySize, LDS_BYTES) != hipSuccess) { fprintf(stderr, "kernel_launch: hipFuncSetAttribute failed\n"); grid = -1; return; }
        int per_cu = 0;
        if (hipOccupancyMaxActiveBlocksPerMultiprocessor(&per_cu, (const void*)mk_fwd, NWAVES * 64, LDS_BYTES) != hipSuccess || per_cu < 1) { fprintf(stderr, "kernel_launch: occupancy query reports %d workgroups per CU\n", per_cu); }
        (void)hipGetLastError();
        grid = cus;
    }
    if (grid < 0) return;
    if (hipMemsetAsync((char*)d_ws + WS_CTL, 0, CTL_ZERO_BYTES, stream) != hipSuccess) { fprintf(stderr, "kernel_launch: memset failed\n"); return; }
    Args a{};
    for (int i = 0; i < 27; ++i) a.in[i] = (const float*)d_in[i];
    a.out = (float*)d_out; a.ws = (unsigned char*)d_ws;
#if MK_PER_PHASE
    for (int p = 0; p < N_PHASES; ++p) { a.ph_lo = p; a.ph_hi = p + 1; hipLaunchKernelGGL(mk_fwd, dim3(grid), dim3(NWAVES * 64), LDS_BYTES, stream, a); }
#else
    a.ph_lo = 0; a.ph_hi = 1 << 20;
    hipLaunchKernelGGL(mk_fwd, dim3(grid), dim3(NWAVES * 64), LDS_BYTES, stream, a);
#endif
    const hipError_t le = hipPeekAtLastError();
    if (le != hipSuccess) fprintf(stderr, "kernel_launch: launch failed: %s\n", hipGetErrorName(le));
}
```

```cpp
#include <hip/hip_runtime.h>
#include <cstdio>
#include <cstdint>
__device__ __forceinline__ int hw_lane() { return (int)__builtin_amdgcn_mbcnt_hi(~0u, __builtin_amdgcn_mbcnt_lo(~0u, 0u)); }
#define FRESH_LANE(l) int l = hw_lane(); asm volatile("" : "+v"(l))
#ifndef XH
#define XH 1
#endif
#if XH
typedef _Float16 xres_t;
#else
typedef float xres_t;
#endif
typedef _Float16 xh4_t __attribute__((ext_vector_type(4)));
typedef float xf4_t __attribute__((ext_vector_type(4)));
__device__ __forceinline__ xf4_t xres_ld4(const xres_t* p) {
#if XH
    return __builtin_convertvector(*(const xh4_t*)p, xf4_t);
#else
    return *(const xf4_t*)p;
#endif
}
__device__ __forceinline__ void xres_st4(xres_t* p, xf4_t v) {
#if XH
    *(xh4_t*)p = __builtin_convertvector(v, xh4_t);
#else
    *(xf4_t*)p = v;
#endif
}
typedef _Float16 xh8_t __attribute__((ext_vector_type(8)));
typedef float xf8_t __attribute__((ext_vector_type(8)));
__device__ __forceinline__ void xres_ld8(const xres_t* p, xf4_t& a, xf4_t& b) {
#if XH
    const xf8_t v = __builtin_convertvector(*(const xh8_t*)p, xf8_t); a = (xf4_t){v[0], v[1], v[2], v[3]}; b = (xf4_t){v[4], v[5], v[6], v[7]};
#else
    a = *(const xf4_t*)p; b = *(const xf4_t*)(p + 4);
#endif
}
__device__ __forceinline__ void xres_st8(xres_t* p, xf4_t a, xf4_t b) {
#if XH
    const xf8_t v = {a[0], a[1], a[2], a[3], b[0], b[1], b[2], b[3]}; *(xh8_t*)p = __builtin_convertvector(v, xh8_t);
#else
    *(xf4_t*)p = a; *(xf4_t*)(p + 4) = b;
#endif
}
#ifndef WT_X
#define WT_X 0
#endif
#ifndef WT_H
#define WT_H 0
#endif
#ifndef WT_O
#define WT_O 0
#endif
typedef unsigned wt_v4u __attribute__((ext_vector_type(4)));
__device__ __forceinline__ __amdgpu_buffer_rsrc_t wt_rsrc(const void* base, size_t bytes) { return __builtin_amdgcn_make_buffer_rsrc((void*)base, (short)0, (int)bytes, 0x00020000); }
template <int WT> __device__ __forceinline__ void wt_store16(__amdgpu_buffer_rsrc_t r, unsigned byte_off, wt_v4u v) { __builtin_amdgcn_raw_buffer_store_b128(v, r, (int)byte_off, 0, WT == 1 ? 16 : WT); }
#if XH
__device__ __forceinline__ void xres_st8_wt(__amdgpu_buffer_rsrc_t r, unsigned elem_off, xf4_t a, xf4_t b) {
    const xf8_t v = {a[0], a[1], a[2], a[3], b[0], b[1], b[2], b[3]}; const xh8_t h = __builtin_convertvector(v, xh8_t); wt_store16<WT_X>(r, elem_off * 2u, __builtin_bit_cast(wt_v4u, h)); }
#endif
#define SWIGLU_UOFF 1
#define RMW_PIPE 1
#define ATT_EARLY_KV 1
#define HIN_DEFER 1
#define GU_WGM 4
#ifndef BATCH_LOCAL
#define BATCH_LOCAL 0
#endif
namespace pg8 {
#define PG8_LAS __attribute__((address_space(3)))
typedef unsigned short bf16_t;
typedef short bf16x8 __attribute__((ext_vector_type(8)));
typedef float f32x4 __attribute__((ext_vector_type(4)));
typedef unsigned u32x4 __attribute__((ext_vector_type(4)));
constexpr int BM = 256, BK = 64, HALF = 128, HTB = HALF * BK * 2  , STAGE_BYTES = 8 * HTB, NXCD = 8, WGM = 8;

__host__ __device__ __forceinline__ int lds_byte(int r, int c) { const int st = (r >> 4) * 2 + (c >> 5), rr = r & 15, cc = c & 31, ob = rr * 64 + cc * 2; return st * 1024 + (ob ^ (((ob >> 9) & 1) << 5)); }
__host__ __device__ __forceinline__ void stage_rc(int b, int& R, int& C) { const int st = b / 1024, sb = b % 1024, swz = sb ^ (((sb >> 9) & 1) << 5); R = (st >> 1) * 16 + swz / 64; C = (st & 1) * 32 + (swz % 64) / 2; }
__host__ __device__ __forceinline__ int perm32(int rho) { const int n = rho >> 4, i = rho & 15; return 8 * (i >> 2) + 4 * n + (i & 3); }

__host__ __device__ __forceinline__ size_t img_off(int row, int col, int K) { return ((size_t)(row >> 7) * (K >> 6) + (col >> 6)) * 16384 + lds_byte(row & 127, col & 63); }
__host__ __device__ __forceinline__ int img_row_perm(int n) { const int p = n & 31; return (n & ~31) + 16 * ((p >> 2) & 1) + 4 * (p >> 3) + (p & 3); }
__host__ __device__ __forceinline__ int img_row_perm_adj(int n) { const int g = (n >> 5) & 7; return (n & ~255) + 128 * (g & 1) + 32 * (g >> 1) + (img_row_perm(n) & 31); }
struct Unit { int pm, pn, k0, kq; };
struct Gemm { const bf16_t* A; const bf16_t* Bt; int lda, ldb, nt; };

#ifndef SCHED_RA
#define SCHED_RA 0
#endif
#ifndef SCHED_FDIV
#define SCHED_FDIV 0
#endif
struct Sched {
    int nM, nN, nNr, nwg, G, c, mmode, kchunk, wgm, pm0, pn0, bl, ra;
#ifdef PROBE_DOWN
    int probe_alias = 0;
#endif
    __device__ __forceinline__ void init(int nM_, int nNr_, int ksplit, int kchunk_, int mmode_, int G_, int c_, int wgm_ = WGM, int pm0_ = 0, int pn0_ = 0) { nM = nM_; nNr = nNr_; nN = nNr_ * ksplit; nwg = nM * nN; G = G_; c = c_; mmode = mmode_; kchunk = kchunk_; wgm = wgm_; pm0 = pm0_; pn0 = pn0_;
        bl = (BATCH_LOCAL && G_ == 256 && (nM_ & 7) == 0 && pm0_ == 0 && pn0_ == 0) ? 1 : 0;
        ra = (SCHED_RA && !bl && G_ == 256 && (nwg & 31) == 0 && pm0_ == 0 && pn0_ == 0) ? 1 : 0;
    }
#if SCHED_FDIV
    static __device__ __forceinline__ int fdiv(int a, int b) { return (int)(((float)a + 0.5f) * __builtin_amdgcn_rcpf((float)b)); }
#endif
    __device__ __forceinline__ bool next(int i, Unit& u) const {
        if (bl) {
            const int x = c & 7, r = c >> 3, nMb = nM >> 3; const int L = i * (G >> 3) + r; if (L >= nMb * nN) return false;
            const int vn = L / nMb, vm = L - vn * nMb, kq = vn / nNr; u.pn = vn - kq * nNr; u.k0 = kq * kchunk; u.kq = kq;
            u.pm = 9 * x + (mmode == 0 ? vm : (mmode == 1 ? 1 + vm : 0)); return true; }
        int wgid;
        if (ra) {
            const int x = c & 7, rank = c >> 3, R = nwg >> 5, Rb = R >> 3, Rr = R & 7, Rx = Rb + (x < Rr ? 1 : 0);
            if (i >= Rx) return false;
            wgid = 32 * (x * Rb + (x < Rr ? x : Rr)) + i * 32 + rank;
        } else {
        const long L = (long)i * G + c; if (L >= nwg) return false;
        wgid = (int)L; { const int q = nwg / NXCD, r = nwg % NXCD, xcd = wgid % NXCD, off = wgid / NXCD; wgid = (xcd < r ? xcd * (q + 1) : r * (q + 1) + (xcd - r) * q) + off; }
        }
#if SCHED_FDIV
        const int nig = wgm * nN, gid = fdiv(wgid, nig), fm = gid * wgm, rem = wgid - gid * nig, gsz = (nM - fm) < wgm ? (nM - fm) : wgm;
        const int vn = fdiv(rem, gsz), vm = fm + rem - vn * gsz;
        const int kq = fdiv(vn, nNr); u.pn = pn0 + vn - kq * nNr; u.k0 = kq * kchunk; u.kq = kq;
#else
        const int nig = wgm * nN, gid = wgid / nig, fm = gid * wgm, gsz = (nM - fm) < wgm ? (nM - fm) : wgm;
        const int vm = fm + ((wgid % nig) % gsz), vn = (wgid % nig) / gsz;
        const int kq = vn / nNr; u.pn = pn0 + vn - kq * nNr; u.k0 = kq * kchunk; u.kq = kq;
#endif
        u.pm = (mmode == 0) ? pm0 + vm : ((mmode == 1) ? ((vm >> 3) * 9 + 1 + (vm & 7)) : vm * 9);
#ifdef PROBE_DOWN
        if (probe_alias) u.pm = 1 + (vm & 7);
#endif
        return true;
    }
};

__device__ __forceinline__ unsigned cvt_pk_bf16(float lo, float hi) { unsigned r; asm volatile("v_cvt_pk_bf16_f32 %0, %1, %2" : "=v"(r) : "v"(lo), "v"(hi)); return r; }
__device__ __forceinline__ float silu_f(float g) { return g * __builtin_amdgcn_rcpf(1.0f + __builtin_amdgcn_exp2f(-1.4426950408889634f * g)); }
#ifndef SWIGLU_PK
#define SWIGLU_PK 0
#endif
typedef float f32x2 __attribute__((ext_vector_type(2)));
__device__ __forceinline__ unsigned cvt_pk_bf16_nv(float lo, float hi) { unsigned r; asm("v_cvt_pk_bf16_f32 %0, %1, %2" : "=v"(r) : "v"(lo), "v"(hi)); return r; }
__device__ __forceinline__ unsigned swiglu_pk2(f32x2 g, f32x2 u) {
    const f32x2 c = g * (f32x2){-1.4426950408889634f, -1.4426950408889634f};
    f32x2 e; e.x = __builtin_amdgcn_exp2f(c.x); e.y = __builtin_amdgcn_exp2f(c.y);
    const f32x2 d = e + (f32x2){1.0f, 1.0f};
    f32x2 r; r.x = __builtin_amdgcn_rcpf(d.x); r.y = __builtin_amdgcn_rcpf(d.y);
    const f32x2 o = (g * u) * r;
    return cvt_pk_bf16_nv(o.x, o.y);
}

struct EpiStore {
    static constexpr int ZKIND = 1; static constexpr bool PERM = true, TWICE = false;
    bf16_t* O; int ldc;
    __device__ __forceinline__ void operator()(const f32x4 (&acc)[2][2][4][2], const Unit& u, int wr, int wc, int fr, int fq) const {
        const int row0 = u.pm * BM + wr * 64 + fr, col0 = u.pn * BM + wc * 32 + 8 * fq;
        const __amdgpu_buffer_rsrc_t rs = wt_rsrc(O, (size_t)18432 * ldc * 2);
#pragma unroll
        for (int ai = 0; ai < 2; ++ai)
#pragma unroll
            for (int m = 0; m < 4; ++m) { const unsigned ro = (unsigned)((row0 + ai * HALF + m * 16) * ldc + col0) * 2u;
#pragma unroll
                for (int bj = 0; bj < 2; ++bj) { const f32x4 v0 = acc[ai][bj][m][0], v1 = acc[ai][bj][m][1];
                    u32x4 w; w.x = cvt_pk_bf16(v0[0], v0[1]); w.y = cvt_pk_bf16(v0[2], v0[3]); w.z = cvt_pk_bf16(v1[0], v1[1]); w.w = cvt_pk_bf16(v1[2], v1[3]);
                    wt_store16<WT_O>(rs, ro + bj * HALF * 2, w); } }
    }
};
struct EpiStoreImg {
    static constexpr int ZKIND = 1; static constexpr bool PERM = true, TWICE = false;
    bf16_t* O; int ldc;
    __device__ __forceinline__ void operator()(const f32x4 (&acc)[2][2][4][2], const Unit& u, int wr, int wc, int fr, int fq) const {
        const int row0 = u.pm * BM + wr * 64 + fr, col0 = u.pn * BM + wc * 32 + 8 * fq;
        const __amdgpu_buffer_rsrc_t rs = wt_rsrc(O, (size_t)18432 * ldc * 2);
#pragma unroll
        for (int ai = 0; ai < 2; ++ai)
#pragma unroll
            for (int m = 0; m < 4; ++m) {
#pragma unroll
                for (int bj = 0; bj < 2; ++bj) { const f32x4 v0 = acc[ai][bj][m][0], v1 = acc[ai][bj][m][1];
                    u32x4 w; w.x = cvt_pk_bf16(v0[0], v0[1]); w.y = cvt_pk_bf16(v0[2], v0[3]); w.z = cvt_pk_bf16(v1[0], v1[1]); w.w = cvt_pk_bf16(v1[2], v1[3]);
                    wt_store16<0>(rs, (unsigned)img_off(row0 + ai * HALF + m * 16, col0 + bj * HALF, ldc), w); } }
    }
};
#if defined(PROBE_DOWN) || defined(PROBE_GU)
struct EpiStoreSwap {
    static constexpr int ZKIND = 0; static constexpr bool PERM = true, TWICE = false;
    bf16_t* O; int ldc;
    __device__ __forceinline__ void operator()(const f32x4 (&acc)[2][2][4][2], const Unit& u, int wr, int wc, int fr, int fq) const {
        const bool lo = fr < 8;
        const int row0 = u.pm * BM + wr * 64 + (fr & 7), col0 = u.pn * BM + wc * 64 + (lo ? 0 : 32) + 8 * fq;
        const __amdgpu_buffer_rsrc_t rs = wt_rsrc(O, (size_t)18432 * ldc * 2);
#pragma unroll
        for (int ai = 0; ai < 2; ++ai)
#pragma unroll
            for (int m = 0; m < 4; ++m) { const unsigned ro = (unsigned)((row0 + ai * HALF + m * 16) * ldc + col0) * 2u;
                u32x4 w[2];
#pragma unroll
                for (int bj = 0; bj < 2; ++bj) { const f32x4 v0 = acc[ai][bj][m][0], v1 = acc[ai][bj][m][1];
                    w[bj].x = cvt_pk_bf16(v0[0], v0[1]); w[bj].y = cvt_pk_bf16(v0[2], v0[3]); w[bj].z = cvt_pk_bf16(v1[0], v1[1]); w[bj].w = cvt_pk_bf16(v1[2], v1[3]); }
                u32x4 snd, rcv;
#pragma unroll
                for (int e = 0; e < 4; ++e) { snd[e] = lo ? w[1][e] : w[0][e]; rcv[e] = (unsigned)__builtin_amdgcn_update_dpp(0, (int)snd[e], 0x128, 0xf, 0xf, false); }
                u32x4 dA, dB;
#pragma unroll
                for (int e = 0; e < 4; ++e) { dA[e] = lo ? w[0][e] : rcv[e]; dB[e] = lo ? rcv[e] : w[1][e]; }
                wt_store16<0>(rs, ro, dA); wt_store16<0>(rs, ro + (unsigned)(8 * ldc) * 2u, dB); }
    }
};
template <int PK> struct EpiSwiGLUProbe {
    static constexpr int ZKIND = 0; static constexpr bool PERM = true, TWICE = true;
    bf16_t* O; int ldc;
    __device__ __forceinline__ void operator()(const f32x4 (&acc)[2][2][4][2], const Unit& u, int wr, int wc, int fr, int fq) const {
        const int row0 = u.pm * BM + wr * 64 + fr, col0 = u.pn * HALF + wc * 32 + 8 * fq;
        const __amdgpu_buffer_rsrc_t rs = wt_rsrc(O, (size_t)18432 * ldc * 2);
#pragma unroll
        for (int ai = 0; ai < 2; ++ai)
#pragma unroll
            for (int m = 0; m < 4; ++m) { const unsigned ro = (unsigned)img_off(row0 + ai * HALF + m * 16, col0, ldc);
                const f32x4 g0 = acc[ai][0][m][0], g1 = acc[ai][0][m][1], u0 = acc[ai][1][m][0], u1 = acc[ai][1][m][1];
                u32x4 w;
                if constexpr (PK == 5) {
                    w.x = cvt_pk_bf16(silu_f(g0[0]) * u0[0], silu_f(g0[1]) * u0[1]); w.y = cvt_pk_bf16(silu_f(g0[2]) * u0[2], silu_f(g0[3]) * u0[3]);
                    w.z = cvt_pk_bf16(silu_f(g1[0]) * u1[0], silu_f(g1[1]) * u1[1]); w.w = cvt_pk_bf16(silu_f(g1[2]) * u1[2], silu_f(g1[3]) * u1[3]);
                    if (((unsigned)__builtin_amdgcn_s_getreg((3 << 11) | 20) & 0xFu) == 0u) wt_store16<0>(rs, ro, w); else asm volatile("" :: "v"(w), "v"(ro));
                } else if constexpr (PK == 3) {
                    w.x = cvt_pk_bf16(silu_f(g0[0]) * u0[0], silu_f(g0[1]) * u0[1]); w.y = cvt_pk_bf16(silu_f(g0[2]) * u0[2], silu_f(g0[3]) * u0[3]);
                    w.z = cvt_pk_bf16(silu_f(g1[0]) * u1[0], silu_f(g1[1]) * u1[1]); w.w = cvt_pk_bf16(silu_f(g1[2]) * u1[2], silu_f(g1[3]) * u1[3]);
                    asm volatile("" :: "v"(w), "v"(ro));
                } else {
                    w.x = cvt_pk_bf16(g0[0] + u0[0], g0[1] + u0[1]); w.y = cvt_pk_bf16(g0[2] + u0[2], g0[3] + u0[3]);
                    w.z = cvt_pk_bf16(g1[0] + u1[0], g1[1] + u1[1]); w.w = cvt_pk_bf16(g1[2] + u1[2], g1[3] + u1[3]);
                    wt_store16<0>(rs, ro, w); } }
    }
};
struct EpiNull {
    static constexpr int ZKIND = 0; static constexpr bool PERM = true, TWICE = false;
    __device__ __forceinline__ void operator()(const f32x4 (&acc)[2][2][4][2], const Unit& u, int wr, int wc, int fr, int fq) const {
#pragma unroll
        for (int ai = 0; ai < 2; ++ai)
#pragma unroll
            for (int bj = 0; bj < 2; ++bj)
#pragma unroll
                for (int m = 0; m < 4; ++m)
#pragma unroll
                    for (int n = 0; n < 2; ++n) asm volatile("" :: "v"(acc[ai][bj][m][n]));
    }
};
#endif
#ifndef SWIGLU_UOFF
#define SWIGLU_UOFF 0
#endif
template <bool IMG> struct EpiSwiGLU {
    static constexpr int ZKIND = 0; static constexpr bool PERM = true, TWICE = true;
    bf16_t* O; int ldc;
    __device__ __forceinline__ void operator()(const f32x4 (&acc)[2][2][4][2], const Unit& u, int wr, int wc, int fr, int fq) const {
        const int row0 = u.pm * BM + wr * 64 + fr, col0 = u.pn * HALF + wc * 32 + 8 * fq;
        const __amdgpu_buffer_rsrc_t rs = wt_rsrc(O, (size_t)18432 * ldc * 2);
        const unsigned loff = (unsigned)((fr * 64 + fq * 16) ^ ((fr >> 3) << 5));
        const unsigned ub = (unsigned)((u.pm * 2) * (ldc >> 6) + u.pn * 2 + (wc >> 1)) * 16384u + (unsigned)((wr * 4) * 2 + (wc & 1)) * 1024u, ua = (unsigned)(ldc >> 6) * 16384u;
#pragma unroll
        for (int ai = 0; ai < 2; ++ai)
#pragma unroll
            for (int m = 0; m < 4; ++m) { const unsigned ro = IMG ? (SWIGLU_UOFF ? ub + (unsigned)ai * ua + (unsigned)m * 2048u + loff : (unsigned)img_off(row0 + ai * HALF + m * 16, col0, ldc)) : (unsigned)((row0 + ai * HALF + m * 16) * ldc + col0) * 2u;
                const f32x4 g0 = acc[ai][0][m][0], g1 = acc[ai][0][m][1], u0 = acc[ai][1][m][0], u1 = acc[ai][1][m][1];
                u32x4 w;
#if SWIGLU_PK
                w.x = swiglu_pk2((f32x2){g0[0], g0[1]}, (f32x2){u0[0], u0[1]}); w.y = swiglu_pk2((f32x2){g0[2], g0[3]}, (f32x2){u0[2], u0[3]});
                w.z = swiglu_pk2((f32x2){g1[0], g1[1]}, (f32x2){u1[0], u1[1]}); w.w = swiglu_pk2((f32x2){g1[2], g1[3]}, (f32x2){u1[2], u1[3]});
#else
                w.x = cvt_pk_bf16(silu_f(g0[0]) * u0[0], silu_f(g0[1]) * u0[1]); w.y = cvt_pk_bf16(silu_f(g0[2]) * u0[2], silu_f(g0[3]) * u0[3]);
                w.z = cvt_pk_bf16(silu_f(g1[0]) * u1[0], silu_f(g1[1]) * u1[1]); w.w = cvt_pk_bf16(silu_f(g1[2]) * u1[2], silu_f(g1[3]) * u1[3]);
#endif
                wt_store16<WT_H>(rs, ro, w); }
    }
};
#ifndef RES_PERM
#define RES_PERM 2
#endif
#ifndef RMW_PIPE
#define RMW_PIPE 0
#endif
#ifndef XT
#define XT 0
#endif
#if XT
static_assert(XH && RES_PERM == 2, "the image-layout residual stream needs fp16 storage and the adjacent-halves permutation");
template <bool HALFC  , bool PART> struct EpiResid {
    static constexpr int ZKIND = 2; static constexpr bool PERM = true, TWICE = false;
    xres_t* X; const float* gate; float* P; const float* xin; const float* cin; xres_t* xout;
    __device__ __forceinline__ void operator()(const f32x4 (&acc)[2][2][4][2], const Unit& u, int wr, int wc, int fr, int fq) const {
        const int col0 = u.pn * BM + wc * 64 + 8 * fq;
        const int bq = u.pm / 9, r = (u.pm - bq * 9 == 0) ? 8 : bq;
        const float* gv = gate + (size_t)r * 18432 + col0;
        f32x4 gg[2][2];
#pragma unroll
        for (int bj = 0; bj < 2; ++bj)
#pragma unroll
            for (int n = 0; n < 2; ++n) gg[bj][n] = *(const f32x4*)(gv + bj * 32 + n * 4) * (HALFC ? 0.5f : 1.0f);
        const unsigned loff = (unsigned)((fr * 64 + fq * 16) ^ ((fr >> 3) << 5));
        if constexpr (PART) {
            const __amdgpu_buffer_rsrc_t rs = wt_rsrc(P, (size_t)4 * 2048 * 2048 * 2);
            const unsigned ub = (unsigned)u.kq * (2048u * 4096u) + (unsigned)((bq * 2) * 32 + u.pn * 4 + wc) * 16384u + (unsigned)(wr * 4 * 2) * 1024u;
#pragma unroll
            for (int ai = 0; ai < 2; ++ai)
#pragma unroll
                for (int m = 0; m < 4; ++m)
#pragma unroll
                    for (int bj = 0; bj < 2; ++bj) { const f32x4 a = acc[ai][bj][m][0] * gg[bj][0], b = acc[ai][bj][m][1] * gg[bj][1];
                        const xf8_t v = {a[0], a[1], a[2], a[3], b[0], b[1], b[2], b[3]}; const xh8_t h = __builtin_convertvector(v, xh8_t);
#ifdef XT_PTR
                        *(wt_v4u*)((char*)P + (size_t)(ub + (unsigned)(ai * 32) * 16384u + (unsigned)(m * 2 + bj) * 1024u) + loff) = __builtin_bit_cast(wt_v4u, h); }
#else
                        __builtin_amdgcn_raw_buffer_store_b128(__builtin_bit_cast(wt_v4u, h), rs, (int)loff, (int)(ub + (unsigned)(ai * 32) * 16384u + (unsigned)(m * 2 + bj) * 1024u), 0); }
#endif
        } else {
            const int tin = u.pm - bq * 9;
            const float* src = xin ? (tin == 0 ? cin + (size_t)(bq * 256 + wr * 64 + fr) * 2048 : xin + (size_t)(bq * 2048 + (tin - 1) * 256 + wr * 64 + fr) * 2048) + col0 : nullptr;
            const __amdgpu_buffer_rsrc_t rsx = wt_rsrc(X, (size_t)18432 * 2048 * 2);
            const __amdgpu_buffer_rsrc_t rso = wt_rsrc(xout ? xout : X, (size_t)18432 * 2048 * 2);
            const unsigned ub = (unsigned)((u.pm * 2) * 32 + u.pn * 4 + wc) * 16384u + (unsigned)(wr * 4 * 2) * 1024u;
            const unsigned urm = (unsigned)((u.pm * BM + wr * 64) * 2048 + u.pn * BM + wc * 64) * 2u, lrm = (unsigned)(fr * 2048 + 8 * fq) * 2u;
            const unsigned lst = xout ? lrm : loff;
#pragma unroll
            for (int ai = 0; ai < 2; ++ai)
#pragma unroll
                for (int m = 0; m < 4; ++m) {
                    f32x4 xv[2][2];
                    if (src) { const float* srcp = src + (size_t)(ai * HALF + m * 16) * 2048;
#pragma unroll
                        for (int bj = 0; bj < 2; ++bj)
#pragma unroll
                            for (int n = 0; n < 2; ++n) xv[bj][n] = *(const f32x4*)(srcp + bj * 32 + n * 4);
                    } else {
#pragma unroll
                        for (int bj = 0; bj < 2; ++bj) {
#ifdef XT_PTR
                            const wt_v4u raw = *(const wt_v4u*)((const char*)X + (size_t)(ub + (unsigned)(ai * 32) * 16384u + (unsigned)(m * 2 + bj) * 1024u) + loff);
#else
                            const wt_v4u raw = __builtin_amdgcn_raw_buffer_load_b128(rsx, (int)loff, (int)(ub + (unsigned)(ai * 32) * 16384u + (unsigned)(m * 2 + bj) * 1024u), 0);
#endif
                            const xf8_t t = __builtin_convertvector(__builtin_bit_cast(xh8_t, raw), xf8_t); xv[bj][0] = (f32x4){t[0], t[1], t[2], t[3]}; xv[bj][1] = (f32x4){t[4], t[5], t[6], t[7]}; }
                    }
#pragma unroll
                    for (int bj = 0; bj < 2; ++bj) { const f32x4 a = xv[bj][0] + acc[ai][bj][m][0] * gg[bj][0], b = xv[bj][1] + acc[ai][bj][m][1] * gg[bj][1];
                        const xf8_t v = {a[0], a[1], a[2], a[3], b[0], b[1], b[2], b[3]}; const xh8_t h = __builtin_convertvector(v, xh8_t);
                        const unsigned so = xout ? urm + (unsigned)((ai * HALF + m * 16) * 2048 + bj * 32) * 2u : ub + (unsigned)(ai * 32) * 16384u + (unsigned)(m * 2 + bj) * 1024u;
#ifdef XT_PTR
                        *(wt_v4u*)((char*)(xout ? xout : X) + (size_t)so + lst) = __builtin_bit_cast(wt_v4u, h); }
#else
                        __builtin_amdgcn_raw_buffer_store_b128(__builtin_bit_cast(wt_v4u, h), rso, (int)lst, (int)so, 0); }
#endif
                    if (m & 1) asm volatile("" ::: "memory"); }
        }
    }
};
#else
template <bool HALFC  , bool PART> struct EpiResid {
    static constexpr int ZKIND = 2; static constexpr bool PERM = RES_PERM != 0, TWICE = false;
    xres_t* X; const float* gate; float* P; const float* xin; const float* cin; xres_t* xout  ;
    __device__ __forceinline__ void operator()(const f32x4 (&acc)[2][2][4][2], const Unit& u, int wr, int wc, int fr, int fq) const {
        constexpr int NS = PERM ? 4 : 16;
        constexpr int BJS = RES_PERM == 2 ? 32 : HALF;
        const int col0 = u.pn * BM + wc * (RES_PERM == 2 ? 64 : 32) + (PERM ? 8 : 4) * fq;
        const int bq = u.pm / 9, r = (u.pm - bq * 9 == 0) ? 8 : bq;
        const float* gv = gate + (size_t)r * 18432 + col0;
        f32x4 gg[2][2];
#pragma unroll
        for (int bj = 0; bj < 2; ++bj)
#pragma unroll
            for (int n = 0; n < 2; ++n) gg[bj][n] = *(const f32x4*)(gv + bj * BJS + n * NS) * (HALFC ? 0.5f : 1.0f);
        if constexpr (PART) {
            xres_t* base = (xres_t*)P + ((size_t)u.kq * 2048 + (size_t)(bq * BM + wr * 64 + fr)) * 2048 + col0;
#if XH
            const __amdgpu_buffer_rsrc_t rs = wt_rsrc(P, (size_t)4 * 2048 * 2048 * 2);
#endif
#pragma unroll
            for (int ai = 0; ai < 2; ++ai)
#pragma unroll
                for (int m = 0; m < 4; ++m) { xres_t* rowp = base + (size_t)(ai * HALF + m * 16) * 2048;
#pragma unroll
                    for (int bj = 0; bj < 2; ++bj) {
#if XH
                        if constexpr (PERM) xres_st8_wt(rs, (unsigned)(rowp + bj * BJS - (xres_t*)P), acc[ai][bj][m][0] * gg[bj][0], acc[ai][bj][m][1] * gg[bj][1]);
#else
                        if constexpr (PERM) xres_st8(rowp + bj * BJS, acc[ai][bj][m][0] * gg[bj][0], acc[ai][bj][m][1] * gg[bj][1]);
#endif
                        else { xres_st4(rowp + bj * BJS, acc[ai][bj][m][0] * gg[bj][0]); xres_st4(rowp + bj * BJS + 16, acc[ai][bj][m][1] * gg[bj][1]); } } }
        } else {
            const int row0 = u.pm * BM + wr * 64 + fr;
#if XH
            const __amdgpu_buffer_rsrc_t rsx = wt_rsrc(X, (size_t)18432 * 2048 * 2);
#endif
            const int tin = u.pm - bq * 9;
            const float* src = xin ? (tin == 0 ? cin + (size_t)(bq * 256 + wr * 64 + fr) * 2048 : xin + (size_t)(bq * 2048 + (tin - 1) * 256 + wr * 64 + fr) * 2048) + col0 : nullptr;
#if XH && RMW_PIPE
            if constexpr (PERM) if (!src) {
                xh8_t raw[2][2][2];
                xres_t* const xb = X + (size_t)row0 * 2048 + col0;
#define RP_LOAD(slot_, p_) do { _Pragma("unroll") for (int g_ = 0; g_ < 2; ++g_) _Pragma("unroll") for (int bj = 0; bj < 2; ++bj) \
                    raw[slot_][g_][bj] = *(const xh8_t*)(xb + (size_t)((((p_) * 2 + g_) >> 2) * HALF + (((p_) * 2 + g_) & 3) * 16) * 2048 + bj * BJS); } while (0)
                RP_LOAD(0, 0);
#pragma unroll
                for (int p = 0; p < 4; ++p) {
                    if (p < 3) { if (p & 1) RP_LOAD(0, p + 1); else RP_LOAD(1, p + 1); }
                    asm volatile("" ::: "memory");
#pragma unroll
                    for (int g_ = 0; g_ < 2; ++g_) { const int ai = (p * 2 + g_) >> 2, m = (p * 2 + g_) & 3; xres_t* rowp = xb + (size_t)(ai * HALF + m * 16) * 2048;
#pragma unroll
                        for (int bj = 0; bj < 2; ++bj) { const xf8_t t = __builtin_convertvector(raw[p & 1][g_][bj], xf8_t);
                            const f32x4 x0 = (f32x4){t[0], t[1], t[2], t[3]}, x1 = (f32x4){t[4], t[5], t[6], t[7]};
                            xres_st8_wt(rsx, (unsigned)(rowp + bj * BJS - X), x0 + acc[ai][bj][m][0] * gg[bj][0], x1 + acc[ai][bj][m][1] * gg[bj][1]); } }
                    asm volatile("" ::: "memory");
                }
#undef RP_LOAD
                return;
            }
#endif
#pragma unroll
            for (int ai = 0; ai < 2; ++ai)
#pragma unroll
                for (int m = 0; m < 4; ++m) { xres_t* rowp = X + (size_t)(row0 + ai * HALF + m * 16) * 2048 + col0;
                    f32x4 xv[2][2];
                    if (src) { const float* srcp = src + (size_t)(ai * HALF + m * 16) * 2048;
#pragma unroll
                        for (int bj = 0; bj < 2; ++bj)
#pragma unroll
                            for (int n = 0; n < 2; ++n) xv[bj][n] = *(const f32x4*)(srcp + bj * BJS + n * NS);
                    } else {
#pragma unroll
                        for (int bj = 0; bj < 2; ++bj) {
                            if constexpr (PERM) xres_ld8(rowp + bj * BJS, xv[bj][0], xv[bj][1]);
                            else { xv[bj][0] = xres_ld4(rowp + bj * BJS); xv[bj][1] = xres_ld4(rowp + bj * BJS + 16); } }
                    }
#pragma unroll
                    for (int bj = 0; bj < 2; ++bj) {
#if XH
                        if constexpr (PERM) xres_st8_wt(rsx, (unsigned)(rowp + bj * BJS - X), xv[bj][0] + acc[ai][bj][m][0] * gg[bj][0], xv[bj][1] + acc[ai][bj][m][1] * gg[bj][1]);
#else
                        if constexpr (PERM) xres_st8(rowp + bj * BJS, xv[bj][0] + acc[ai][bj][m][0] * gg[bj][0], xv[bj][1] + acc[ai][bj][m][1] * gg[bj][1]);
#endif
                        else { xres_st4(rowp + bj * BJS, xv[bj][0] + acc[ai][bj][m][0] * gg[bj][0]); xres_st4(rowp + bj * BJS + 16, xv[bj][1] + acc[ai][bj][m][1] * gg[bj][1]); } }
                    if (m & 1) asm volatile("" ::: "memory"); }
        }
    }
};

#endif

template <class Epi, bool IMGA = false, bool IMGB = false, bool KREV = false>
__device__ __forceinline__ void gemm_phase(PG8_LAS unsigned char* lds, const Gemm g, const Sched& S, const Epi& E, const int wid  ) {
    FRESH_LANE(lane);
    const int tid = wid * 64 + lane, wr = wid >> 2, wc = wid & 3, fr = lane & 15, fq = lane >> 4;
    const int nt = g.nt;
    unsigned voffA[2], voffB[2];
#pragma unroll
    for (int i = 0; i < 2; ++i) { int R, C; stage_rc(tid * 16 + i * 8192, R, C); const int Rb = Epi::PERM ? ((R & ~31) + perm32(R & 31)) : R;
        voffA[i] = IMGA ? (unsigned)(tid * 16 + i * 8192) : (unsigned)(R * g.lda + C) * 2u; voffB[i] = IMGB ? (unsigned)(tid * 16 + i * 8192) : (unsigned)(Rb * g.ldb + C) * 2u; }
    const size_t kabsA = IMGA ? (size_t)HTB : (size_t)(BK * 2), kabsB = IMGB ? (size_t)HTB : (size_t)(BK * 2);
    const size_t kstepA = KREV ? (size_t)0 - kabsA : kabsA, kstepB = KREV ? (size_t)0 - kabsB : kabsB;
#define PG8_K0A(k0) ((IMGA ? (size_t)((k0) >> 6) * HTB : (size_t)(k0) * 2) + (KREV ? (size_t)(nt - 1) * kabsA : (size_t)0))
#define PG8_K0B(k0) ((IMGB ? (size_t)((k0) >> 6) * HTB : (size_t)(k0) * 2) + (KREV ? (size_t)(nt - 1) * kabsB : (size_t)0))
    const size_t hstepA = (size_t)HALF * g.lda * 2, hstepB = (size_t)HALF * g.ldb * 2;
    const size_t tstepA = 2 * hstepA, tstepB = 2 * hstepB;
    const unsigned ldsw = (unsigned)wid * 1024u;
    const int aoff = lds_byte(wr * 64 + fr, fq * 8), boff = lds_byte(wc * 32 + fr, fq * 8);
#define PG8_SA(b, h) (((b) * 2 + (h)) * HTB)
#define PG8_SB(b, h) ((4 + (b) * 2 + (h)) * HTB)
#ifndef ALIGN_EPI
#define ALIGN_EPI 1
#endif
#ifndef PG8_AUX_A
#define PG8_AUX_A 0
#endif
#ifndef PG8_AUX_B
#define PG8_AUX_B 0
#endif
#define PG8_STAGE(bufoff, gbase, voff) do { _Pragma("unroll") for (int _i = 0; _i < 2; ++_i) { \
        if ((bufoff) < 4 * HTB) __builtin_amdgcn_global_load_lds((const unsigned*)((const char*)(gbase) + (voff)[_i]), (PG8_LAS unsigned*)(lds + (bufoff) + ldsw + _i * 8192), 16, 0, PG8_AUX_A); \
        else __builtin_amdgcn_global_load_lds((const unsigned*)((const char*)(gbase) + (voff)[_i]), (PG8_LAS unsigned*)(lds + (bufoff) + ldsw + _i * 8192), 16, 0, PG8_AUX_B); } } while (0)
#define PG8_LDA(dst, b, h) do { _Pragma("unroll") for (int m = 0; m < 4; ++m) _Pragma("unroll") for (int k = 0; k < 2; ++k) dst[m][k] = *(const PG8_LAS bf16x8*)(lds + PG8_SA(b, h) + aoff + m * 2048 + k * 1024); } while (0)
#define PG8_LDB(dst, b, h) do { _Pragma("unroll") for (int n = 0; n < 2; ++n) _Pragma("unroll") for (int k = 0; k < 2; ++k) dst[n][k] = *(const PG8_LAS bf16x8*)(lds + PG8_SB(b, h) + boff + n * 2048 + k * 1024); } while (0)
#define PG8_MMA(ai, bj, At, Bt) do { __builtin_amdgcn_s_setprio(1); _Pragma("unroll") for (int m = 0; m < 4; ++m) _Pragma("unroll") for (int n = 0; n < 2; ++n) _Pragma("unroll") for (int k = 0; k < 2; ++k) \
        acc[ai][bj][m][n] = __builtin_amdgcn_mfma_f32_16x16x32_bf16(Bt[n][k], At[m][k], acc[ai][bj][m][n], 0, 0, 0); __builtin_amdgcn_s_setprio(0); } while (0)
#define PG8_MMA0(ai, bj, At, Bt) do { __builtin_amdgcn_s_setprio(1); _Pragma("unroll") for (int m = 0; m < 4; ++m) _Pragma("unroll") for (int n = 0; n < 2; ++n) { \
        acc[ai][bj][m][n] = __builtin_amdgcn_mfma_f32_16x16x32_bf16(Bt[n][0], At[m][0], (f32x4){0.f, 0.f, 0.f, 0.f}, 0, 0, 0); \
        acc[ai][bj][m][n] = __builtin_amdgcn_mfma_f32_16x16x32_bf16(Bt[n][1], At[m][1], acc[ai][bj][m][n], 0, 0, 0); } __builtin_amdgcn_s_setprio(0); } while (0)
#ifndef ACC_ZERO_MFMA
#define ACC_ZERO_MFMA 1
#endif
#ifndef ACC_ZERO_WHICH
#define ACC_ZERO_WHICH 1
#endif
#ifndef STORE_SLACK
#define STORE_SLACK 0
#endif
#ifndef EARLY_FRAG
#define EARLY_FRAG 0
#endif
#ifndef LATE_NEXT_BR
#define LATE_NEXT_BR 1
#endif
#ifndef ACC_PEEL_WHICH
#define ACC_PEEL_WHICH 0
#endif
#define ACC_PEEL_SEL(E_) ((ACC_PEEL_WHICH & 2) && E_::ZKIND == 1 || (ACC_PEEL_WHICH & 4) && E_::ZKIND == 2)
#define ACC_ZERO_SEL(E_) ((ACC_ZERO_WHICH & 1) && E_::TWICE || (ACC_ZERO_WHICH & 2) && E_::ZKIND == 1 || (ACC_ZERO_WHICH & 4) && E_::ZKIND == 2)
#if ACC_ZERO_MFMA
#define PG8_MMAF(first, ai, bj, At, Bt) do { if (first) PG8_MMA0(ai, bj, At, Bt); else PG8_MMA(ai, bj, At, Bt); } while (0)
#else
#define PG8_MMAF(first, ai, bj, At, Bt) PG8_MMA(ai, bj, At, Bt)
#endif
#define PG8_WAIT_V(n) asm volatile("s_waitcnt vmcnt(" #n ")" ::: "memory")
#define PG8_WAIT_L(n) asm volatile("s_waitcnt lgkmcnt(" #n ")" ::: "memory")
#define PG8_BAR __builtin_amdgcn_s_barrier()
#define PG8_SCHED __builtin_amdgcn_sched_barrier(0)
#ifndef PG8_SP2
#define PG8_SP2 1
#endif
#if PG8_SP2
#define PG8_W8() PG8_WAIT_V(8)
#define PG8_W0S() PG8_WAIT_V(16)
#define PG8_ITER(MM) PG8_ITERX(MM, 0, PG8_W8)
#define PG8_ITERX(MM, SKIPLD, W0) do { const bool last = (t == nt - 2); \
        const char* a1 = cA + (size_t)(t + 1) * kstepA; \
        const char* a2 = last ? nA : cA + (size_t)(t + 2) * kstepA; const char* b2 = last ? nB : cB + (size_t)(t + 2) * kstepB; \
        const char* a3 = a2 + kstepA; const char* b3 = b2 + kstepB; \
        if (!((SKIPLD) & 1)) { PG8_LDB(B0, 0, 0); PG8_LDB(B1, 0, 1); PG8_SCHED; } if (!((SKIPLD) & 2)) { PG8_LDA(At, 0, 0); } PG8_STAGE(PG8_SA(1, 1), a1 + hstepA, voffA); \
        W0(); PG8_WAIT_L(0); PG8_BAR; MM(0, 0, At, B0); MM(0, 1, At, B1); PG8_BAR; PG8_SCHED; \
        PG8_LDA(At, 0, 1); PG8_STAGE(PG8_SB(0, 0), b2, voffB); PG8_STAGE(PG8_SB(0, 1), b2 + hstepB, voffB); PG8_STAGE(PG8_SA(0, 0), a2, voffA); \
        W0(); PG8_WAIT_L(0); PG8_BAR; MM(1, 0, At, B0); MM(1, 1, At, B1); PG8_BAR; PG8_SCHED; \
        PG8_LDB(B0, 1, 0); PG8_LDB(B1, 1, 1); PG8_SCHED; PG8_LDA(At, 1, 0); PG8_STAGE(PG8_SA(0, 1), a2 + hstepA, voffA); \
        PG8_WAIT_V(8); PG8_WAIT_L(0); PG8_BAR; PG8_MMA(0, 0, At, B0); PG8_MMA(0, 1, At, B1); PG8_BAR; PG8_SCHED; \
        PG8_LDA(At, 1, 1); PG8_STAGE(PG8_SB(1, 0), b3, voffB); PG8_STAGE(PG8_SB(1, 1), b3 + hstepB, voffB); PG8_STAGE(PG8_SA(1, 0), a3, voffA); \
        PG8_WAIT_V(8); PG8_WAIT_L(0); PG8_BAR; PG8_MMA(1, 0, At, B0); PG8_MMA(1, 1, At, B1); PG8_BAR; PG8_SCHED; } while (0)
#endif
    Unit cur, nxt; int ui = 0;
    if (!S.next(0, cur)) return;
    f32x4 acc[2][2][4][2];
#pragma unroll
    for (int a = 0; a < 2; ++a)
#pragma unroll
        for (int b = 0; b < 2; ++b)
#pragma unroll
            for (int m = 0; m < 4; ++m)
#pragma unroll
                for (int n = 0; n < 2; ++n) acc[a][b][m][n] = (f32x4){0.f, 0.f, 0.f, 0.f};
    bf16x8 At[4][2], B0[2][2], B1[2][2];
    const char* cA = (const char*)g.A + (size_t)cur.pm * tstepA + PG8_K0A(cur.k0); const char* cB = (const char*)g.Bt + (size_t)cur.pn * tstepB + PG8_K0B(cur.k0);
#ifndef PG8_SP2
#define PG8_SP2 1
#endif
#if PG8_SP2
    PG8_STAGE(PG8_SB(0, 0), cB, voffB); PG8_STAGE(PG8_SB(0, 1), cB + hstepB, voffB); PG8_STAGE(PG8_SA(0, 0), cA, voffA); PG8_STAGE(PG8_SA(0, 1), cA + hstepA, voffA);
    if (wr == 1) PG8_BAR;
    PG8_WAIT_V(2); PG8_BAR;
    PG8_STAGE(PG8_SB(1, 0), cB + kstepB, voffB); PG8_STAGE(PG8_SA(1, 0), cA + kstepA, voffA); PG8_STAGE(PG8_SB(1, 1), cB + hstepB + kstepB, voffB);
    if constexpr (STORE_SLACK && ACC_ZERO_MFMA && Epi::TWICE) { PG8_WAIT_V(0); } else { PG8_WAIT_V(6); }
    PG8_BAR;
#else
    PG8_STAGE(PG8_SB(0, 0), cB, voffB); PG8_STAGE(PG8_SA(0, 0), cA, voffA); PG8_STAGE(PG8_SB(0, 1), cB + hstepB, voffB); PG8_STAGE(PG8_SA(0, 1), cA + hstepA, voffA);
    if (wr == 1) PG8_BAR;
    PG8_WAIT_V(4); PG8_BAR;
    PG8_STAGE(PG8_SB(1, 0), cB + kstepB, voffB); PG8_STAGE(PG8_SA(1, 0), cA + kstepA, voffA); PG8_STAGE(PG8_SB(1, 1), cB + hstepB + kstepB, voffB);
    PG8_WAIT_V(6); PG8_BAR;
#endif
#if PG8_SP2 && ACC_ZERO_MFMA && EARLY_FRAG
    if constexpr (ACC_ZERO_SEL(Epi)) { if (EARLY_FRAG & 1) { PG8_LDB(B0, 0, 0); PG8_LDB(B1, 0, 1); PG8_SCHED; } if (EARLY_FRAG & 2) { PG8_LDA(At, 0, 0); } }
#endif
    for (;;) {
#define PG8_NEXT() has_next = S.next(ui + 1, nxt); \
        nA = has_next ? (const char*)g.A + (size_t)nxt.pm * tstepA + PG8_K0A(nxt.k0) : cA; nB = has_next ? (const char*)g.Bt + (size_t)nxt.pn * tstepB + PG8_K0B(nxt.k0) : cB
        bool has_next; const char* nA = cA; const char* nB = cB;
#if PG8_SP2 && ACC_ZERO_MFMA
        if constexpr (ACC_ZERO_SEL(Epi)) {
            { const int t = 0; if constexpr (STORE_SLACK && Epi::TWICE) PG8_ITERX(PG8_MMA0, EARLY_FRAG, PG8_W0S); else PG8_ITERX(PG8_MMA0, EARLY_FRAG, PG8_W8); }
            PG8_NEXT();
            for (int t = 2; t < nt; t += 2) PG8_ITER(PG8_MMA);
        } else if constexpr (ACC_PEEL_SEL(Epi)) {
            { const int t = 0; PG8_ITER(PG8_MMA); }
            PG8_NEXT();
            for (int t = 2; t < nt; t += 2) PG8_ITER(PG8_MMA);
        } else if constexpr (LATE_NEXT_BR) { for (int t = 0; t < nt; t += 2) { if (t == 2) { PG8_NEXT(); } PG8_ITER(PG8_MMA); } }
        else { PG8_NEXT(); for (int t = 0; t < nt; t += 2) PG8_ITER(PG8_MMA); }
#elif PG8_SP2
        PG8_NEXT(); for (int t = 0; t < nt; t += 2) PG8_ITER(PG8_MMA);
#else
        PG8_NEXT();
        for (int t = 0; t < nt; t += 2) {
            const bool last = (t == nt - 2);
            const char* a1 = cA + (size_t)(t + 1) * kstepA;
            const char* a2 = last ? nA : cA + (size_t)(t + 2) * kstepA; const char* b2 = last ? nB : cB + (size_t)(t + 2) * kstepB;
            const char* a3 = a2 + kstepA; const char* b3 = b2 + kstepB;
#if PG8_SP2
            PG8_LDB(B0, 0, 0); PG8_LDB(B1, 0, 1); PG8_SCHED; PG8_LDA(At, 0, 0); PG8_STAGE(PG8_SA(1, 1), a1 + hstepA, voffA);
            PG8_WAIT_V(8); PG8_WAIT_L(0); PG8_BAR; PG8_MMAF(t == 0, 0, 0, At, B0); PG8_MMAF(t == 0, 0, 1, At, B1); PG8_BAR; PG8_SCHED;
            PG8_LDA(At, 0, 1); PG8_STAGE(PG8_SB(0, 0), b2, voffB); PG8_STAGE(PG8_SB(0, 1), b2 + hstepB, voffB); PG8_STAGE(PG8_SA(0, 0), a2, voffA);
            PG8_WAIT_V(8); PG8_WAIT_L(0); PG8_BAR; PG8_MMAF(t == 0, 1, 0, At, B0); PG8_MMAF(t == 0, 1, 1, At, B1); PG8_BAR; PG8_SCHED;
            PG8_LDB(B0, 1, 0); PG8_LDB(B1, 1, 1); PG8_SCHED; PG8_LDA(At, 1, 0); PG8_STAGE(PG8_SA(0, 1), a2 + hstepA, voffA);
            PG8_WAIT_V(8); PG8_WAIT_L(0); PG8_BAR; PG8_MMA(0, 0, At, B0); PG8_MMA(0, 1, At, B1); PG8_BAR; PG8_SCHED;
            PG8_LDA(At, 1, 1); PG8_STAGE(PG8_SB(1, 0), b3, voffB); PG8_STAGE(PG8_SB(1, 1), b3 + hstepB, voffB); PG8_STAGE(PG8_SA(1, 0), a3, voffA);
            PG8_WAIT_V(8); PG8_WAIT_L(0); PG8_BAR; PG8_MMA(1, 0, At, B0); PG8_MMA(1, 1, At, B1); PG8_BAR; PG8_SCHED;
#else
            PG8_LDB(B0, 0, 0); PG8_SCHED; PG8_LDA(At, 0, 0); PG8_STAGE(PG8_SA(1, 1), a1 + hstepA, voffA);
            PG8_WAIT_L(8); PG8_BAR; PG8_WAIT_L(0); PG8_MMA(0, 0, At, B0); PG8_BAR; PG8_SCHED;
            PG8_LDB(B1, 0, 1); PG8_STAGE(PG8_SB(0, 0), b2, voffB);
            PG8_BAR; PG8_WAIT_L(0); PG8_MMA(0, 1, At, B1); PG8_BAR;
            PG8_LDA(At, 0, 1); PG8_STAGE(PG8_SA(0, 0), a2, voffA);
            PG8_BAR; PG8_WAIT_L(0); PG8_MMA(1, 0, At, B0); PG8_BAR; PG8_SCHED;
            PG8_STAGE(PG8_SB(0, 1), b2 + hstepB, voffB);
            PG8_WAIT_V(6); PG8_BAR; PG8_MMA(1, 1, At, B1); PG8_BAR;
            PG8_LDB(B0, 1, 0); PG8_SCHED; PG8_LDA(At, 1, 0); PG8_STAGE(PG8_SA(0, 1), a2 + hstepA, voffA);
            PG8_WAIT_L(8); PG8_BAR; PG8_WAIT_L(0); PG8_MMA(0, 0, At, B0); PG8_BAR; PG8_SCHED;
            PG8_LDB(B1, 1, 1); PG8_STAGE(PG8_SB(1, 0), b3, voffB);
            PG8_BAR; PG8_WAIT_L(0); PG8_MMA(0, 1, At, B1); PG8_BAR;
            PG8_LDA(At, 1, 1); PG8_STAGE(PG8_SA(1, 0), a3, voffA);
            PG8_BAR; PG8_WAIT_L(0); PG8_MMA(1, 0, At, B0); PG8_BAR; PG8_SCHED;
            PG8_STAGE(PG8_SB(1, 1), b3 + hstepB, voffB);
            PG8_WAIT_V(6); PG8_BAR; PG8_MMA(1, 1, At, B1); PG8_BAR;
#endif
        }
#endif
#if ALIGN_EPI
        if (wr == 0) PG8_BAR;
#endif
#if PG8_SP2 && ACC_ZERO_MFMA && EARLY_FRAG
        if constexpr (ACC_ZERO_SEL(Epi)) { if (EARLY_FRAG & 1) { PG8_LDB(B0, 0, 0); PG8_LDB(B1, 0, 1); PG8_SCHED; } if (EARLY_FRAG & 2) { PG8_LDA(At, 0, 0); } }
#endif
        E(acc, cur, wr, wc, fr, fq);
#ifdef EPI2X
        if constexpr (Epi::TWICE) { asm volatile("" ::: "memory"); E(acc, cur, wr, wc, fr, fq); }
#endif
        if (!has_next) break;
        if constexpr (!(ACC_ZERO_MFMA && PG8_SP2 && ACC_ZERO_SEL(Epi))) {
#pragma unroll
        for (int a = 0; a < 2; ++a)
#pragma unroll
            for (int b = 0; b < 2; ++b)
#pragma unroll
                for (int m = 0; m < 4; ++m)
#pragma unroll
                    for (int n = 0; n < 2; ++n) acc[a][b][m][n] = (f32x4){0.f, 0.f, 0.f, 0.f};
        }
        cur = nxt; cA = nA; cB = nB; ++ui;
#if ALIGN_EPI
        if (wr == 1) PG8_BAR;
#endif
    }
#if !ALIGN_EPI
    if (wr == 0) PG8_BAR;
#endif
    PG8_WAIT_V(0);
    PG8_BAR;
#undef PG8_NEXT
#undef PG8_K0A
#undef PG8_K0B
#undef PG8_SA
#undef PG8_SB
#undef PG8_STAGE
#undef PG8_LDA
#undef PG8_LDB
#undef PG8_MMA
#undef PG8_WAIT_V
#undef PG8_WAIT_L
#undef PG8_BAR
#undef PG8_SCHED
}
}
#ifndef ATT_EARLY_KV
#define ATT_EARLY_KV 0
#endif
#ifndef Q2_IMG
#define Q2_IMG 0
#endif
#ifndef AO_IMG
#define AO_IMG 0
#endif
namespace att {
#define ATT_LAS __attribute__((address_space(3)))
typedef unsigned short bf16_t;
using bf16x8 = __attribute__((ext_vector_type(8))) short;
using s16x4  = __attribute__((ext_vector_type(4))) short;
using f32x16 = __attribute__((ext_vector_type(16))) float;
using f32x4v = __attribute__((ext_vector_type(4))) float;
using u32x4  = __attribute__((ext_vector_type(4))) unsigned;
constexpr int NW = 8, QBLK = 32, KVBLK = 64;
constexpr float THR = 8.f;
constexpr int SHM_V = KVBLK * 128 * 2;
#define SBAR() __builtin_amdgcn_sched_barrier(0)
__device__ __forceinline__ int crow(int r, int hi) { return (r & 3) + 8 * (r >> 2) + 4 * hi; }
__device__ __forceinline__ unsigned cvtpk(float lo, float hi) { unsigned r; asm volatile("v_cvt_pk_bf16_f32 %0, %1, %2" : "=v"(r) : "v"(lo), "v"(hi)); return r; }
__device__ __forceinline__ float bflo(unsigned w) { return __uint_as_float(w << 16); }
__device__ __forceinline__ float bfhi(unsigned w) { return __uint_as_float(w & 0xffff0000u); }
#ifndef KSWZ16
#define KSWZ16 1
#endif
template <int KP> __device__ __forceinline__ int kswz(int row, int colB) {
#if KSWZ16
    if constexpr (KP == 256) return row * KP + (colB ^ ((row & 15) << 4));
    else return row * KP + (colB ^ (((row >> 1) & 7) << 4));
#else
    return row * KP + (colB ^ ((row & 7) << 4));
#endif
}

struct AttnArgs {
    const bf16_t* Q; const bf16_t* K; const bf16_t* KR; const bf16_t* V; bf16_t* O;
    int ldq, ldk, ldkr, ldv, ldo;
    int seq;
    int t0;
    const float* cosT; const float* sinT;
    const float* qgain;
    int qcol0;
    int orow0, ocol0;
};

#ifndef MLA_NQR
#define MLA_NQR 7
#endif
template <int MODE> struct Cfg;
template <> struct Cfg<0> { static constexpr int DQK = 128; static constexpr float SCALE = 0.088388347648318440f; static constexpr int NLD = 4, NQR = 8; };
template <> struct Cfg<1> { static constexpr int DQK = 192; static constexpr float SCALE = 0.072168783648703220f; static constexpr int NLD = 5, NQR = MLA_NQR; };

template <int MODE> __device__ __forceinline__ void partialSM(f32x16& p0, f32x16& p1, float& m_reg, float& mn, float& alpha) {
    constexpr float SC = Cfg<MODE>::SCALE, C = SC * 1.4426950408889634f;
    float pmax = p0[0];
#pragma unroll
    for (int r = 1; r < 16; ++r) pmax = fmaxf(pmax, p0[r]);
#pragma unroll
    for (int r = 0; r < 16; ++r) pmax = fmaxf(pmax, p1[r]);
    { auto rr = __builtin_amdgcn_permlane32_swap(__float_as_uint(pmax), __float_as_uint(pmax), false, false);
      pmax = fmaxf(__uint_as_float(rr[0]), __uint_as_float(rr[1])); }
    if (__builtin_expect(__all(pmax - m_reg <= THR / SC), 1)) { mn = m_reg; alpha = 1.f; }
    else { mn = fmaxf(m_reg, pmax); alpha = __builtin_amdgcn_exp2f((m_reg - mn) * C); m_reg = mn; }
    const float mnC = -mn * C;
#pragma unroll
    for (int r = 0; r < 16; ++r) p0[r] = fmaf(p0[r], C, mnC);
#pragma unroll
    for (int r = 0; r < 16; ++r) p1[r] = fmaf(p1[r], C, mnC);
#pragma unroll
    for (int r = 0; r < 16; ++r) p0[r] = __builtin_amdgcn_exp2f(p0[r]);
}
__device__ __forceinline__ void finishSM(f32x16& p0, f32x16& p1, float alpha, float& l_reg, bf16x8& pa0, bf16x8& pa1, bf16x8& pa2, bf16x8& pa3) {
#pragma unroll
    for (int r = 0; r < 16; ++r) p1[r] = __builtin_amdgcn_exp2f(p1[r]);
    float ps = 0;
#pragma unroll
    for (int r = 0; r < 16; ++r) ps += p0[r];
#pragma unroll
    for (int r = 0; r < 16; ++r) ps += p1[r];
    { auto rr = __builtin_amdgcn_permlane32_swap(__float_as_uint(ps), __float_as_uint(ps), false, false);
      ps = __uint_as_float(rr[0]) + __uint_as_float(rr[1]); }
    l_reg = l_reg * alpha + ps;
#define PK4(P, BASE, OUT) do { unsigned a0 = cvtpk(P[BASE + 0], P[BASE + 1]), a1 = cvtpk(P[BASE + 2], P[BASE + 3]);   \
    unsigned b0 = cvtpk(P[BASE + 4], P[BASE + 5]), b1 = cvtpk(P[BASE + 6], P[BASE + 7]);                              \
    auto r0 = __builtin_amdgcn_permlane32_swap(a0, b0, false, false); auto r1 = __builtin_amdgcn_permlane32_swap(a1, b1, false, false); \
    u32x4 w = {r0[0], r1[0], r0[1], r1[1]}; OUT = __builtin_bit_cast(bf16x8, w); } while (0)
    PK4(p0, 0, pa0); PK4(p0, 8, pa1); PK4(p1, 0, pa2); PK4(p1, 8, pa3);
#undef PK4
}
template <int MODE> __device__ __forceinline__ void qkt(f32x16& p0, f32x16& p1, const ATT_LAS unsigned char* Ks, const bf16x8* qr, const ATT_LAS unsigned char* qx, int r32, int hi) {
    constexpr int DQK = Cfg<MODE>::DQK, KP = DQK * 2;
    p0 = f32x16{}; p1 = f32x16{};
#pragma unroll
    for (int d0 = 0; d0 < DQK / 16; ++d0) { const int cb = (d0 * 16 + hi * 8) * 2;
        const bf16x8 b0 = *(const ATT_LAS bf16x8*)(Ks + kswz<KP>(r32, cb));
        const bf16x8 b1 = *(const ATT_LAS bf16x8*)(Ks + kswz<KP>(32 + r32, cb));
        constexpr int NQR = Cfg<MODE>::NQR;
        const bf16x8 q = d0 < NQR ? qr[d0 < NQR ? d0 : 0] : *(const ATT_LAS bf16x8*)(qx + (d0 - NQR) * 1024);
        p0 = __builtin_amdgcn_mfma_f32_32x32x16_bf16(b0, q, p0, 0, 0, 0);
        p1 = __builtin_amdgcn_mfma_f32_32x32x16_bf16(b1, q, p1, 0, 0, 0); }
}
__device__ __forceinline__ int v_st(int k, int c) { const int kk = (k & ~0xC) | ((k & 4) << 1) | ((k & 8) >> 1); return ((kk >> 3) * 4 + (c >> 5)) * 512 + ((kk & 7) * 32 + (c & 31)) * 2; }
__device__ __forceinline__ int v_rd_base(int lane) { return ((lane & 3) << 3) | (((lane >> 2) & 3) << 6) | (((lane >> 4) & 1) << 5) | (((lane >> 5) & 1) << 8); }
constexpr int v_rd_off(int d0, int ks, int half) { return d0 * 512 + ks * 4096 + half * 2048; }
template <int OFF> __device__ __forceinline__ s16x4 tr_read(int vb) {
    s16x4 r; asm volatile("ds_read_b64_tr_b16 %0, %1 offset:%2" : "=&v"(r) : "v"(vb), "i"(OFF) : "memory"); return r;
}
template <int D0> __device__ __forceinline__ void pv_one(f32x16& od, int vb, bf16x8 pa0, bf16x8 pa1, bf16x8 pa2, bf16x8 pa3) {
    const s16x4 l0 = tr_read<v_rd_off(D0, 0, 0)>(vb), h0 = tr_read<v_rd_off(D0, 0, 1)>(vb), l1 = tr_read<v_rd_off(D0, 1, 0)>(vb), h1 = tr_read<v_rd_off(D0, 1, 1)>(vb);
    const s16x4 l2 = tr_read<v_rd_off(D0, 2, 0)>(vb), h2 = tr_read<v_rd_off(D0, 2, 1)>(vb), l3 = tr_read<v_rd_off(D0, 3, 0)>(vb), h3 = tr_read<v_rd_off(D0, 3, 1)>(vb);
    asm volatile("s_waitcnt lgkmcnt(0)" ::: "memory"); SBAR();
#define PK(L, H) (bf16x8){L[0], L[1], L[2], L[3], H[0], H[1], H[2], H[3]}
    od = __builtin_amdgcn_mfma_f32_32x32x16_bf16(pa0, PK(l0, h0), od, 0, 0, 0);
    od = __builtin_amdgcn_mfma_f32_32x32x16_bf16(pa1, PK(l1, h1), od, 0, 0, 0);
    od = __builtin_amdgcn_mfma_f32_32x32x16_bf16(pa2, PK(l2, h2), od, 0, 0, 0);
    od = __builtin_amdgcn_mfma_f32_32x32x16_bf16(pa3, PK(l3, h3), od, 0, 0, 0);
#undef PK
}
__device__ __forceinline__ void pv_d0(f32x16* o, int vb, bf16x8 pa0, bf16x8 pa1, bf16x8 pa2, bf16x8 pa3) {
    pv_one<0>(o[0], vb, pa0, pa1, pa2, pa3); pv_one<1>(o[1], vb, pa0, pa1, pa2, pa3); pv_one<2>(o[2], vb, pa0, pa1, pa2, pa3); pv_one<3>(o[3], vb, pa0, pa1, pa2, pa3);
}
#ifndef ATT_ILVQ
#define ATT_ILVQ 0
#endif
#ifndef ATT_ILVQ_PF
#define ATT_ILVQ_PF 0
#endif
#ifndef ATT_ILVP
#define ATT_ILVP 3
#endif
template <int MODE, int D0> __device__ __forceinline__ void fs_slice(f32x16& p0, f32x16& p1, float& ps, float alpha, float& l_reg, bf16x8& pa0, bf16x8& pa1, bf16x8& pa2, bf16x8& pa3) {
    constexpr int N = Cfg<MODE>::DQK / 16;
#define PK4(P, BASE, OUT) do { unsigned a0 = cvtpk(P[BASE + 0], P[BASE + 1]), a1 = cvtpk(P[BASE + 2], P[BASE + 3]);   \
    unsigned b0 = cvtpk(P[BASE + 4], P[BASE + 5]), b1 = cvtpk(P[BASE + 6], P[BASE + 7]);                              \
    auto r0 = __builtin_amdgcn_permlane32_swap(a0, b0, false, false); auto r1 = __builtin_amdgcn_permlane32_swap(a1, b1, false, false); \
    u32x4 w = {r0[0], r1[0], r0[1], r1[1]}; OUT = __builtin_bit_cast(bf16x8, w); } while (0)
    if constexpr (D0 < 4) {
#pragma unroll
        for (int r = 0; r < 4; ++r) p1[D0 * 4 + r] = __builtin_amdgcn_exp2f(p1[D0 * 4 + r]);
    } else if constexpr (N == 12 && D0 < 8) {
#pragma unroll
        for (int r = 0; r < 4; ++r) { ps += p0[(D0 - 4) * 4 + r]; ps += p1[(D0 - 4) * 4 + r]; }
    } else if constexpr (N == 8 && D0 < 6) {
#pragma unroll
        for (int r = 0; r < 8; ++r) { ps += p0[(D0 - 4) * 8 + r]; ps += p1[(D0 - 4) * 8 + r]; }
    } else {
        constexpr int F = D0 - (N == 12 ? 8 : 6);
        if constexpr (F == 0) { auto rr = __builtin_amdgcn_permlane32_swap(__float_as_uint(ps), __float_as_uint(ps), false, false);
            ps = __uint_as_float(rr[0]) + __uint_as_float(rr[1]); l_reg = l_reg * alpha + ps; }
        if constexpr (N == 12) { if constexpr (F == 0) PK4(p0, 0, pa0); else if constexpr (F == 1) PK4(p0, 8, pa1); else if constexpr (F == 2) PK4(p1, 0, pa2); else PK4(p1, 8, pa3); }
        else { if constexpr (F == 0) { PK4(p0, 0, pa0); PK4(p0, 8, pa1); } else { PK4(p1, 0, pa2); PK4(p1, 8, pa3); } }
    }
#undef PK4
}
template <int MODE, int D0> __device__ __forceinline__ void qkfs_step(f32x16& n0, f32x16& n1, const ATT_LAS unsigned char* Ks, const bf16x8* qr, const ATT_LAS unsigned char* qx, int r32, int hi,
        bf16x8 kb0, bf16x8 kb1, bf16x8 qc, f32x16& p0, f32x16& p1, float& ps, float alpha, float& l_reg, bf16x8& pa0, bf16x8& pa1, bf16x8& pa2, bf16x8& pa3) {
    constexpr int DQK = Cfg<MODE>::DQK, KP = DQK * 2, N = DQK / 16, NQR = Cfg<MODE>::NQR;
#if ATT_ILVQ_PF
    bf16x8 nb0 = kb0, nb1 = kb1, qn = qc;
    if constexpr (D0 + 1 < N) { const int cb = ((D0 + 1) * 16 + hi * 8) * 2;
        nb0 = *(const ATT_LAS bf16x8*)(Ks + kswz<KP>(r32, cb)); nb1 = *(const ATT_LAS bf16x8*)(Ks + kswz<KP>(32 + r32, cb));
        if constexpr (D0 + 1 >= NQR) qn = *(const ATT_LAS bf16x8*)(qx + (D0 + 1 - NQR) * 1024); }
    bf16x8 q = qc; if constexpr (D0 < NQR) q = qr[D0 < NQR ? D0 : 0];
#else
    { const int cb = (D0 * 16 + hi * 8) * 2; kb0 = *(const ATT_LAS bf16x8*)(Ks + kswz<KP>(r32, cb)); kb1 = *(const ATT_LAS bf16x8*)(Ks + kswz<KP>(32 + r32, cb)); }
    bf16x8 q; if constexpr (D0 < NQR) q = qr[D0 < NQR ? D0 : 0]; else q = *(const ATT_LAS bf16x8*)(qx + (D0 - NQR) * 1024);
    const bf16x8 nb0 = kb0, nb1 = kb1, qn = qc;
#endif
    if constexpr (D0 == 0) { n0 = __builtin_amdgcn_mfma_f32_32x32x16_bf16(kb0, q, f32x16{}, 0, 0, 0); n1 = __builtin_amdgcn_mfma_f32_32x32x16_bf16(kb1, q, f32x16{}, 0, 0, 0); }
    else { n0 = __builtin_amdgcn_mfma_f32_32x32x16_bf16(kb0, q, n0, 0, 0, 0); n1 = __builtin_amdgcn_mfma_f32_32x32x16_bf16(kb1, q, n1, 0, 0, 0); }
    fs_slice<MODE, D0>(p0, p1, ps, alpha, l_reg, pa0, pa1, pa2, pa3);
    SBAR();
    if constexpr (D0 + 1 < N) qkfs_step<MODE, D0 + 1>(n0, n1, Ks, qr, qx, r32, hi, nb0, nb1, qn, p0, p1, ps, alpha, l_reg, pa0, pa1, pa2, pa3);
}
template <int MODE> __device__ __forceinline__ void qkt_fs(f32x16& n0, f32x16& n1, const ATT_LAS unsigned char* Ks, const bf16x8* qr, const ATT_LAS unsigned char* qx, int r32, int hi,
        f32x16& p0, f32x16& p1, float alpha, float& l_reg, bf16x8& pa0, bf16x8& pa1, bf16x8& pa2, bf16x8& pa3) {
    constexpr int KP = Cfg<MODE>::DQK * 2, NQR = Cfg<MODE>::NQR;
    const int cb = (hi * 8) * 2;
    const bf16x8 kb0 = *(const ATT_LAS bf16x8*)(Ks + kswz<KP>(r32, cb)), kb1 = *(const ATT_LAS bf16x8*)(Ks + kswz<KP>(32 + r32, cb));
    bf16x8 qc = kb0; if constexpr (NQR == 0) qc = *(const ATT_LAS bf16x8*)(qx);
    float ps = 0.f;
    qkfs_step<MODE, 0>(n0, n1, Ks, qr, qx, r32, hi, kb0, kb1, qc, p0, p1, ps, alpha, l_reg, pa0, pa1, pa2, pa3);
}
template <int MODE> __device__ __forceinline__ void pv_ps(f32x16* o, int vb, bf16x8 pa0, bf16x8 pa1, bf16x8 pa2, bf16x8 pa3, f32x16& p0, f32x16& p1, float& m_reg, float& mn, float& alpha) {
    constexpr float SC = Cfg<MODE>::SCALE, C = SC * 1.4426950408889634f;
    pv_one<0>(o[0], vb, pa0, pa1, pa2, pa3);
    float pmax = p0[0];
#pragma unroll
    for (int r = 1; r < 16; ++r) pmax = fmaxf(pmax, p0[r]);
#pragma unroll
    for (int r = 0; r < 16; ++r) pmax = fmaxf(pmax, p1[r]);
    { auto rr = __builtin_amdgcn_permlane32_swap(__float_as_uint(pmax), __float_as_uint(pmax), false, false);
      pmax = fmaxf(__uint_as_float(rr[0]), __uint_as_float(rr[1])); }
    pv_one<1>(o[1], vb, pa0, pa1, pa2, pa3);
    const bool keep = __all(pmax - m_reg <= THR / SC);
    const float mx = fmaxf(m_reg, pmax);
    mn = keep ? m_reg : mx;
    const float al = __builtin_amdgcn_exp2f((m_reg - mn) * C);
    alpha = keep ? 1.f : al; m_reg = mn;
    const float mnC = -mn * C;
#pragma unroll
    for (int r = 0; r < 16; ++r) p0[r] = fmaf(p0[r], C, mnC);
#pragma unroll
    for (int r = 0; r < 4; ++r) p0[r] = __builtin_amdgcn_exp2f(p0[r]);
    pv_one<2>(o[2], vb, pa0, pa1, pa2, pa3);
#pragma unroll
    for (int r = 0; r < 16; ++r) p1[r] = fmaf(p1[r], C, mnC);
#pragma unroll
    for (int r = 4; r < 10; ++r) p0[r] = __builtin_amdgcn_exp2f(p0[r]);
    pv_one<3>(o[3], vb, pa0, pa1, pa2, pa3);
#pragma unroll
    for (int r = 10; r < 16; ++r) p0[r] = __builtin_amdgcn_exp2f(p0[r]);
    asm volatile("" : "+v"(p0), "+v"(p1));
    SBAR();
}
__device__ __forceinline__ void rope8(float (&y)[8], const f32x4v c, const f32x4v s) {
#pragma unroll
    for (int p = 0; p < 4; ++p) { const float x0 = y[2 * p], x1 = y[2 * p + 1]; y[2 * p] = x0 * c[p] - x1 * s[p]; y[2 * p + 1] = x0 * s[p] + x1 * c[p]; }
}
__device__ __forceinline__ void unpack8(const u32x4 w, float (&y)[8]) { y[0] = bflo(w.x); y[1] = bfhi(w.x); y[2] = bflo(w.y); y[3] = bfhi(w.y); y[4] = bflo(w.z); y[5] = bfhi(w.z); y[6] = bflo(w.w); y[7] = bfhi(w.w); }
__device__ __forceinline__ u32x4 pack8(const float (&y)[8]) { u32x4 w; w.x = cvtpk(y[0], y[1]); w.y = cvtpk(y[2], y[3]); w.z = cvtpk(y[4], y[5]); w.w = cvtpk(y[6], y[7]); return w; }

template <int MODE, int SDEPTH>
__device__ __forceinline__ void attn_unit(const AttnArgs& a, ATT_LAS unsigned char* lds, const int wid  ) {
    constexpr int DQK = Cfg<MODE>::DQK, KP = DQK * 2, SHM_K = KVBLK * KP, ND0 = DQK / 16;
    int lane = hw_lane(); asm volatile("" : "+v"(lane));
    const int tid = wid * 64 + lane, r32 = lane & 31, hi = lane >> 5;
    ATT_LAS unsigned char* V_lds = lds; ATT_LAS unsigned char* K_lds = lds + 2 * SHM_V;
    ATT_LAS float* wsf = (ATT_LAS float*)(lds + 2 * SHM_V + 2 * SHM_K) + wid * 64; ATT_LAS float* li_l = wsf; ATT_LAS float* al_l = wsf + 32;
    float m_reg = -1e30f, l_reg = 0; f32x16 o[4] = {}; bf16x8 qr[8];
    constexpr int NQR = Cfg<MODE>::NQR, QXB = (12 - NQR) * 1024;
    ATT_LAS unsigned char* qx = lds + 2 * SHM_V + 2 * SHM_K + 2048 + wid * QXB + lane * 16;
    const int sr = tid >> 4, sc = (tid & 15) * 8, vst0 = v_st(sr, sc), vst1 = v_st(32 + sr, sc);
    const int kst0 = kswz<KP>(sr, sc * 2), kst1 = kswz<KP>(32 + sr, sc * 2);
    const int krr = tid >> 3, krc = (tid & 7) * 8, kst2 = kswz<KP>(krr, (128 + krc) * 2);
    const int vb0 = (int)(unsigned)(uintptr_t)V_lds + v_rd_base(lane);
    const char* Kh = (const char*)a.K; const char* Vh = (const char*)a.V; const char* KRh = (const char*)a.KR;
    const unsigned offK = (unsigned)(sr * a.ldk + sc) * 2u, offV = (unsigned)(sr * a.ldv + sc) * 2u, offR = (unsigned)(krr * a.ldkr + krc) * 2u;
    const size_t tK = (size_t)a.ldk * (2 * KVBLK), tV = (size_t)a.ldv * (2 * KVBLK), tR = (size_t)a.ldkr * (2 * KVBLK);
    struct { bf16x8 vs0, vs1, ks0, ks1, kr; } sr_[SDEPTH];
#define SLOAD(i, j) do { const char* vb_ = Vh + (size_t)(j) * tV; const char* kb_ = Kh + (size_t)(j) * tK; \
    sr_[i].vs0 = *(const bf16x8*)(vb_ + offV); sr_[i].vs1 = *(const bf16x8*)(vb_ + (tV >> 1) + offV); \
    sr_[i].ks0 = *(const bf16x8*)(kb_ + offK); sr_[i].ks1 = *(const bf16x8*)(kb_ + (tK >> 1) + offK); \
    if constexpr (MODE == 1) sr_[i].kr = *(const bf16x8*)(KRh + (size_t)(j) * tR + offR); } while (0)
#define SWRITE(b, i) do { *(ATT_LAS bf16x8*)(V_lds + (b) * SHM_V + vst0) = sr_[i].vs0; *(ATT_LAS bf16x8*)(V_lds + (b) * SHM_V + vst1) = sr_[i].vs1; \
    *(ATT_LAS bf16x8*)(K_lds + (b) * SHM_K + kst0) = sr_[i].ks0; *(ATT_LAS bf16x8*)(K_lds + (b) * SHM_K + kst1) = sr_[i].ks1; \
    if constexpr (MODE == 1) *(ATT_LAS bf16x8*)(K_lds + (b) * SHM_K + kst2) = sr_[i].kr; } while (0)
#define SWAIT() do { if constexpr (SDEPTH == 1) asm volatile("s_waitcnt vmcnt(0)" ::: "memory"); else if constexpr (MODE == 1) asm volatile("s_waitcnt vmcnt(5)" ::: "memory"); else asm volatile("s_waitcnt vmcnt(4)" ::: "memory"); } while (0)
#define RESC(al) do { if (__any((al) < 1.f)) { if (hi == 0) al_l[r32] = (al); asm volatile("s_waitcnt lgkmcnt(0)" ::: "memory"); \
    _Pragma("unroll") for (int d = 0; d < 4; ++d) _Pragma("unroll") for (int r = 0; r < 16; ++r) o[d][r] *= al_l[crow(r, hi)]; } } while (0)
    f32x16 pA0, pA1, pB0, pB1; float mnA, mnB, alA, alB; bf16x8 pa0, pa1, pa2, pa3; const int NT = a.seq / KVBLK;
    constexpr int SE = 0, SO = SDEPTH - 1;
#if ATT_EARLY_KV
    SLOAD(SE, 0);
#endif
    {
        int tq = hw_lane(); asm volatile("" : "+v"(tq)); const int r32 = tq & 31, hi = (tq >> 5) & 1;
        const bf16_t* Qw = a.Q + (long)(wid * QBLK + r32) * a.ldq + hi * 8;
#if Q2_IMG
#define QSRC(d0_) (MODE == 1 ? (const void*)((const char*)a.Q + pg8::img_off(a.orow0 + wid * QBLK + r32, a.qcol0 + (d0_) * 16 + hi * 8, 3072)) : (const void*)(Qw + (d0_) * 16))
#else
#define QSRC(d0_) ((const void*)(Qw + (d0_) * 16))
#endif
        const int t = a.t0 + wid * QBLK + r32;
        if constexpr (MODE == 0) {
            u32x4 raw[8]; float ss = 0.f;
#pragma unroll
            for (int d0 = 0; d0 < 8; ++d0) { raw[d0] = *(const u32x4*)(Qw + d0 * 16); float y[8]; unpack8(raw[d0], y);
#pragma unroll
                for (int e = 0; e < 8; ++e) ss += y[e] * y[e]; }
            ss += __shfl_xor(ss, 32);
            const float rstd = 1.0f / sqrtf(ss * (1.0f / 128.0f) + 1e-6f);
#pragma unroll
            for (int d0 = 0; d0 < 8; ++d0) { float y[8]; unpack8(raw[d0], y);
                const f32x4v g0 = *(const f32x4v*)(a.qgain + d0 * 16 + hi * 8), g1 = *(const f32x4v*)(a.qgain + d0 * 16 + hi * 8 + 4);
#pragma unroll
                for (int e = 0; e < 4; ++e) { y[e] = y[e] * rstd * g0[e]; y[4 + e] = y[4 + e] * rstd * g1[e]; }
                if (a.t0 >= 0) { const f32x4v c = *(const f32x4v*)(a.cosT + (long)t * 64 + d0 * 8 + hi * 4), s = *(const f32x4v*)(a.sinT + (long)t * 64 + d0 * 8 + hi * 4); rope8(y, c, s); }
                qr[d0] = __builtin_bit_cast(bf16x8, pack8(y)); }
        } else {
            ATT_LAS unsigned char* qxw = lds + 2 * SHM_V + 2 * SHM_K + 2048 + wid * QXB + (tq & 63) * 16;
#pragma unroll
            for (int d0 = 0; d0 < 8; ++d0) { const bf16x8 v = *(const bf16x8*)QSRC(d0); if (d0 < NQR) qr[d0 < NQR ? d0 : 0] = v; else *(ATT_LAS bf16x8*)(qxw + (d0 - NQR) * 1024) = v; }
#pragma unroll
            for (int d0 = 8; d0 < 12; ++d0) { const u32x4 raw = *(const u32x4*)QSRC(d0); float y[8]; unpack8(raw, y);
                const f32x4v c = *(const f32x4v*)(a.cosT + (long)t * 32 + (d0 - 8) * 8 + hi * 4), s = *(const f32x4v*)(a.sinT + (long)t * 32 + (d0 - 8) * 8 + hi * 4); rope8(y, c, s);
                *(ATT_LAS u32x4*)(qxw + (d0 - NQR) * 1024) = pack8(y); }
            asm volatile("s_waitcnt lgkmcnt(0)" ::: "memory");
        }
    }
#if ATT_EARLY_KV
    asm volatile("s_waitcnt vmcnt(0)" ::: "memory"); SWRITE(0, SE); __syncthreads();
#else
    SLOAD(SE, 0); asm volatile("s_waitcnt vmcnt(0)" ::: "memory"); SWRITE(0, SE); __syncthreads();
#endif
    qkt<MODE>(pA0, pA1, K_lds, qr, qx, r32, hi); partialSM<MODE>(pA0, pA1, m_reg, mnA, alA);
    SLOAD(SO, 1); if constexpr (SDEPTH == 2) { if (2 < NT) SLOAD(SE, 2); }
    SWAIT(); SWRITE(1, SO); __syncthreads();
    for (int j = 1; j + 1 < NT; j += 2) {
        if constexpr (SDEPTH == 1) { SLOAD(SO, j + 1); }
        constexpr bool ILVQ = ((ATT_ILVQ >> MODE) & 1) != 0, ILVP = ((ATT_ILVP >> MODE) & 1) != 0;
        SBAR(); if constexpr (ILVQ) qkt_fs<MODE>(pB0, pB1, K_lds + SHM_K, qr, qx, r32, hi, pA0, pA1, alA, l_reg, pa0, pa1, pa2, pa3);
        else { qkt<MODE>(pB0, pB1, K_lds + SHM_K, qr, qx, r32, hi); finishSM(pA0, pA1, alA, l_reg, pa0, pa1, pa2, pa3); } SBAR();
        if constexpr (SDEPTH == 2) { SLOAD(SO, j + SDEPTH); } SBAR();
        if constexpr (ILVP) pv_ps<MODE>(o, vb0, pa0, pa1, pa2, pa3, pB0, pB1, m_reg, mnB, alB);
        else { pv_d0(o, vb0, pa0, pa1, pa2, pa3); partialSM<MODE>(pB0, pB1, m_reg, mnB, alB); }
        __syncthreads(); SWAIT(); SWRITE(0, SE);
        RESC(alB); __syncthreads();
        if constexpr (SDEPTH == 1) { SLOAD(SE, j + 2); }
        SBAR(); if constexpr (ILVQ) qkt_fs<MODE>(pA0, pA1, K_lds, qr, qx, r32, hi, pB0, pB1, alB, l_reg, pa0, pa1, pa2, pa3);
        else { qkt<MODE>(pA0, pA1, K_lds, qr, qx, r32, hi); finishSM(pB0, pB1, alB, l_reg, pa0, pa1, pa2, pa3); } SBAR();
        if constexpr (SDEPTH == 2) { if (j + 3 < NT) SLOAD(SE, j + 1 + SDEPTH); } SBAR();
        if constexpr (ILVP) pv_ps<MODE>(o, vb0 + SHM_V, pa0, pa1, pa2, pa3, pA0, pA1, m_reg, mnA, alA);
        else { pv_d0(o, vb0 + SHM_V, pa0, pa1, pa2, pa3); partialSM<MODE>(pA0, pA1, m_reg, mnA, alA); }
        __syncthreads(); SWAIT(); SWRITE(1, SO);
        RESC(alA); __syncthreads();
    }
    SBAR(); qkt<MODE>(pB0, pB1, K_lds + SHM_K, qr, qx, r32, hi);
    finishSM(pA0, pA1, alA, l_reg, pa0, pa1, pa2, pa3); SBAR();
    pv_d0(o, vb0, pa0, pa1, pa2, pa3); partialSM<MODE>(pB0, pB1, m_reg, mnB, alB);
    __syncthreads(); RESC(alB);
    finishSM(pB0, pB1, alB, l_reg, pa0, pa1, pa2, pa3); SBAR();
    pv_d0(o, vb0 + SHM_V, pa0, pa1, pa2, pa3);
    int te = hw_lane(); asm volatile("" : "+v"(te));
    { const int lane = te & 63, r32 = lane & 31, hi = lane >> 5;
    if (hi == 0) li_l[r32] = l_reg; asm volatile("s_waitcnt lgkmcnt(0)" ::: "memory");
    float rli[16];
#pragma unroll
    for (int r = 0; r < 16; ++r) rli[r] = __builtin_amdgcn_rcpf(li_l[crow(r, hi)]);
    __syncthreads();
    ATT_LAS bf16_t* stg = (ATT_LAS bf16_t*)lds + wid * 4096;
#pragma unroll
    for (int r = 0; r < 16; ++r) { const int orow = crow(r, hi);
#pragma unroll
        for (int d0 = 0; d0 < 4; ++d0) stg[orow * 128 + d0 * 32 + r32] = (bf16_t)(cvtpk(o[d0][r] * rli[r], 0.f) & 0xffffu); }
    asm volatile("s_waitcnt lgkmcnt(0)" ::: "memory");
#if AO_IMG
    {
      const int ch = lane & 15, C = a.ocol0 + ch * 8;
#pragma unroll
      for (int i = 0; i < 8; ++i) { const int row = i * 4 + (lane >> 4), R = a.orow0 + wid * QBLK + row; const u32x4 v = *(const ATT_LAS u32x4*)(stg + row * 128 + ch * 8);
          *(u32x4*)((char*)a.O + pg8::img_off(R, C, 2048)) = v; } }
#else
    { char* Ow = (char*)(a.O + (size_t)(wid * QBLK) * a.ldo); const unsigned offO = (unsigned)((lane >> 4) * a.ldo + (lane & 15) * 8) * 2u; const size_t rO = (size_t)a.ldo * 8;
#pragma unroll
      for (int i = 0; i < 8; ++i) { const int row = i * 4 + (lane >> 4), ch = lane & 15; const u32x4 v = *(const ATT_LAS u32x4*)(stg + row * 128 + ch * 8); *(u32x4*)(Ow + i * rO + offO) = v; } }
#endif
    }
    asm volatile("s_waitcnt lgkmcnt(0)" ::: "memory");
    __syncthreads();
#undef SLOAD
#undef SWRITE
#undef SWAIT
#undef RESC
}

constexpr int NST = 3, KN_B = 16384, V_B = 16384, KR_B = 8192, OFF_KN = 0, OFF_V = NST * KN_B, OFF_KR = OFF_V + NST * V_B, OFF_WS = OFF_KR + NST * KR_B, ATT_DMA_LDS = OFF_WS + 2048;
template <int MODE> __device__ __forceinline__ void qkt2(f32x16& p0, f32x16& p1, const ATT_LAS unsigned char* Kn, const ATT_LAS unsigned char* Kr, const bf16x8* qr, int r32, int hi) {
    p0 = f32x16{}; p1 = f32x16{};
    const int x = (r32 & 7) << 4;
#pragma unroll
    for (int d0 = 0; d0 < 8; ++d0) { const int cb = (d0 * 16 + hi * 8) * 2;
        const bf16x8 b0 = *(const ATT_LAS bf16x8*)(Kn + r32 * 256 + (cb ^ x));
        const bf16x8 b1 = *(const ATT_LAS bf16x8*)(Kn + (32 + r32) * 256 + (cb ^ x));
        p0 = __builtin_amdgcn_mfma_f32_32x32x16_bf16(b0, qr[d0], p0, 0, 0, 0);
        p1 = __builtin_amdgcn_mfma_f32_32x32x16_bf16(b1, qr[d0], p1, 0, 0, 0); }
    if constexpr (MODE == 1) {
#pragma unroll
        for (int d0 = 8; d0 < 12; ++d0) { const int cb = ((d0 - 8) * 16 + hi * 8) * 2;
            const bf16x8 b0 = *(const ATT_LAS bf16x8*)(Kr + r32 * 128 + (cb ^ x));
            const bf16x8 b1 = *(const ATT_LAS bf16x8*)(Kr + (32 + r32) * 128 + (cb ^ x));
            p0 = __builtin_amdgcn_mfma_f32_32x32x16_bf16(b0, qr[d0], p0, 0, 0, 0);
            p1 = __builtin_amdgcn_mfma_f32_32x32x16_bf16(b1, qr[d0], p1, 0, 0, 0); }
    }
}
template <int MODE, bool STAG>
__device__ __forceinline__ void attn_unit_dma(const AttnArgs& a, ATT_LAS unsigned char* lds, const int wid  ) {
    constexpr int ND0 = Cfg<MODE>::DQK / 16;
    int lane = hw_lane(); asm volatile("" : "+v"(lane));
    const int r32 = lane & 31, hi = lane >> 5;
    ATT_LAS float* wsf = (ATT_LAS float*)(lds + OFF_WS) + wid * 64; ATT_LAS float* li_l = wsf; ATT_LAS float* al_l = wsf + 32;
    const char* Kh = (const char*)a.K; const char* Vh = (const char*)a.V; const char* KRh = (const char*)a.KR;
    const size_t tK = (size_t)a.ldk * (2 * KVBLK), tV = (size_t)a.ldv * (2 * KVBLK), tR = (size_t)a.ldkr * (2 * KVBLK);
    unsigned offKn[2], offVv[2], offKr;
#pragma unroll
    for (int i = 0; i < 2; ++i) { const int p = wid + 8 * i;
        { const int row = p * 4 + (lane >> 4), src = (lane & 15) ^ (row & 7); offKn[i] = (unsigned)(row * a.ldk) * 2u + (unsigned)src * 16u; }
        { const int sI = p * 2 + (lane >> 5), q = lane & 31, kk = (sI >> 2) * 8 + (q >> 2), col = (sI & 3) * 32 + (q & 3) * 8, k = (kk & ~0xC) | ((kk & 4) << 1) | ((kk & 8) >> 1);
          offVv[i] = (unsigned)(k * a.ldv + col) * 2u; } }
    { const int row = wid * 8 + (lane >> 3), src = (lane & 7) ^ (row & 7); offKr = (unsigned)(row * a.ldkr) * 2u + (unsigned)src * 16u; }
#define DMA16(gp, lp) __builtin_amdgcn_global_load_lds((const unsigned*)(gp), (ATT_LAS unsigned*)(lp), 16, 0, 0)
#define ISSUE_K(j, st) do { const char* kb_ = Kh + (size_t)(j) * tK; DMA16(kb_ + offKn[0], lds + OFF_KN + (st) * KN_B + wid * 1024); DMA16(kb_ + offKn[1], lds + OFF_KN + (st) * KN_B + (wid + 8) * 1024); \
    if constexpr (MODE == 1) DMA16(KRh + (size_t)(j) * tR + offKr, lds + OFF_KR + (st) * KR_B + wid * 1024); } while (0)
#define ISSUE_V(j, st) do { const char* vb_ = Vh + (size_t)(j) * tV; DMA16(vb_ + offVv[0], lds + OFF_V + (st) * V_B + wid * 1024); DMA16(vb_ + offVv[1], lds + OFF_V + (st) * V_B + (wid + 8) * 1024); } while (0)
#define WAIT_TILE(full) do { if (full) { if constexpr (MODE == 1) asm volatile("s_waitcnt vmcnt(5)" ::: "memory"); else asm volatile("s_waitcnt vmcnt(4)" ::: "memory"); } else asm volatile("s_waitcnt vmcnt(0)" ::: "memory"); \
    asm volatile("s_waitcnt lgkmcnt(0)" ::: "memory"); __builtin_amdgcn_s_barrier(); asm volatile("" ::: "memory"); } while (0)
    const int NT = a.seq / KVBLK;
    ISSUE_K(0, 0); ISSUE_V(0, 0); ISSUE_K(1, 1);
    float m_reg = -1e30f, l_reg = 0; f32x16 o[4] = {}; bf16x8 qr[ND0];
    {
        int tq = hw_lane(); asm volatile("" : "+v"(tq)); const int r32 = tq & 31, hi = (tq >> 5) & 1;
        const bf16_t* Qw = a.Q + (long)(wid * QBLK + r32) * a.ldq + hi * 8;
        const int t = a.t0 + wid * QBLK + r32;
        if constexpr (MODE == 0) {
            u32x4 raw[8]; float ss = 0.f;
#pragma unroll
            for (int d0 = 0; d0 < 8; ++d0) { raw[d0] = *(const u32x4*)(Qw + d0 * 16); float y[8]; unpack8(raw[d0], y);
#pragma unroll
                for (int e = 0; e < 8; ++e) ss += y[e] * y[e]; }
            ss += __shfl_xor(ss, 32);
            const float rstd = 1.0f / sqrtf(ss * (1.0f / 128.0f) + 1e-6f);
#pragma unroll
            for (int d0 = 0; d0 < 8; ++d0) { float y[8]; unpack8(raw[d0], y);
                const f32x4v g0 = *(const f32x4v*)(a.qgain + d0 * 16 + hi * 8), g1 = *(const f32x4v*)(a.qgain + d0 * 16 + hi * 8 + 4);
#pragma unroll
                for (int e = 0; e < 4; ++e) { y[e] = y[e] * rstd * g0[e]; y[4 + e] = y[4 + e] * rstd * g1[e]; }
                if (a.t0 >= 0) { const f32x4v c = *(const f32x4v*)(a.cosT + (long)t * 64 + d0 * 8 + hi * 4), s = *(const f32x4v*)(a.sinT + (long)t * 64 + d0 * 8 + hi * 4); rope8(y, c, s); }
                qr[d0] = __builtin_bit_cast(bf16x8, pack8(y)); }
        } else {
#pragma unroll
            for (int d0 = 0; d0 < 8; ++d0) qr[d0] = *(const bf16x8*)(Qw + d0 * 16);
#pragma unroll
            for (int d0 = 8; d0 < 12; ++d0) { const u32x4 raw = *(const u32x4*)(Qw + d0 * 16); float y[8]; unpack8(raw, y);
                const f32x4v c = *(const f32x4v*)(a.cosT + (long)t * 32 + (d0 - 8) * 8 + hi * 4), s = *(const f32x4v*)(a.sinT + (long)t * 32 + (d0 - 8) * 8 + hi * 4); rope8(y, c, s);
                qr[d0] = __builtin_bit_cast(bf16x8, pack8(y)); }
        }
    }
    const int vb0 = (int)(unsigned)(uintptr_t)(lds + OFF_V) + v_rd_base(lane);
    const ATT_LAS unsigned char* Kn0 = lds + OFF_KN; const ATT_LAS unsigned char* Kr0 = lds + OFF_KR;
#define RESC(al) do { if (__any((al) < 1.f)) { if (hi == 0) al_l[r32] = (al); asm volatile("s_waitcnt lgkmcnt(0)" ::: "memory"); \
    _Pragma("unroll") for (int d = 0; d < 4; ++d) _Pragma("unroll") for (int r = 0; r < 16; ++r) o[d][r] *= al_l[crow(r, hi)]; } } while (0)
    f32x16 pA0, pA1, pB0, pB1; float mnA, mnB, alA, alB; bf16x8 pa0, pa1, pa2, pa3;
    asm volatile("s_waitcnt vmcnt(0)" ::: "memory"); __builtin_amdgcn_s_barrier(); asm volatile("" ::: "memory");
    int sj = 1;
    const bool isB = STAG && wid >= 4;
#define TILE(S0, S1, mnS, alS, P0, P1, mnP, alP, j) do { \
    const int s_cur = sj, s_prev = (sj == 0 ? 2 : sj - 1), s_next = (sj == 2 ? 0 : sj + 1); \
    if ((j) + 2 < NT) ISSUE_K((j) + 2, s_prev); \
    if ((j) + 1 < NT) ISSUE_V((j) + 1, s_next); \
    if (isB) { partialSM<MODE>(P0, P1, m_reg, mnP, alP); RESC(alP); } \
    SBAR(); qkt2<MODE>(S0, S1, Kn0 + s_cur * KN_B, Kr0 + s_cur * KR_B, qr, r32, hi); \
    finishSM(P0, P1, alP, l_reg, pa0, pa1, pa2, pa3); SBAR(); \
    pv_d0(o, vb0 + s_prev * V_B, pa0, pa1, pa2, pa3); \
    if (!isB) { partialSM<MODE>(S0, S1, m_reg, mnS, alS); RESC(alS); } \
    WAIT_TILE((j) + 2 < NT); \
    sj = s_next; } while (0)
    if (2 < NT) ISSUE_K(2, 2);
    ISSUE_V(1, 1);
    SBAR(); qkt2<MODE>(pA0, pA1, Kn0, Kr0, qr, r32, hi); if (!isB) partialSM<MODE>(pA0, pA1, m_reg, mnA, alA);
    WAIT_TILE(2 < NT);
    for (int j = 1; j + 1 < NT; j += 2) {
        TILE(pB0, pB1, mnB, alB, pA0, pA1, mnA, alA, j);
        TILE(pA0, pA1, mnA, alA, pB0, pB1, mnB, alB, j + 1);
    }
    TILE(pB0, pB1, mnB, alB, pA0, pA1, mnA, alA, NT - 1);
    if (isB) { partialSM<MODE>(pB0, pB1, m_reg, mnB, alB); RESC(alB); }
    { const int s_prev = (sj == 0 ? 2 : sj - 1);
      finishSM(pB0, pB1, alB, l_reg, pa0, pa1, pa2, pa3); SBAR();
      pv_d0(o, vb0 + s_prev * V_B, pa0, pa1, pa2, pa3); }
    int te = hw_lane(); asm volatile("" : "+v"(te));
    { const int lane = te & 63, r32 = lane & 31, hi = lane >> 5;
    if (hi == 0) li_l[r32] = l_reg; asm volatile("s_waitcnt lgkmcnt(0)" ::: "memory");
    float rli[16];
#pragma unroll
    for (int r = 0; r < 16; ++r) rli[r] = __builtin_amdgcn_rcpf(li_l[crow(r, hi)]);
    asm volatile("s_waitcnt lgkmcnt(0)" ::: "memory"); __builtin_amdgcn_s_barrier(); asm volatile("" ::: "memory");
    ATT_LAS bf16_t* stg = (ATT_LAS bf16_t*)lds + wid * 4096;
#pragma unroll
    for (int r = 0; r < 16; ++r) { const int orow = crow(r, hi);
#pragma unroll
        for (int d0 = 0; d0 < 4; ++d0) stg[orow * 128 + d0 * 32 + r32] = (bf16_t)(cvtpk(o[d0][r] * rli[r], 0.f) & 0xffffu); }
    asm volatile("s_waitcnt lgkmcnt(0)" ::: "memory");
#if AO_IMG
    {
      const int ch = lane & 15, C = a.ocol0 + ch * 8;
#pragma unroll
      for (int i = 0; i < 8; ++i) { const int row = i * 4 + (lane >> 4), R = a.orow0 + wid * QBLK + row; const u32x4 v = *(const ATT_LAS u32x4*)(stg + row * 128 + ch * 8);
          *(u32x4*)((char*)a.O + pg8::img_off(R, C, 2048)) = v; } }
#else
    { char* Ow = (char*)(a.O + (size_t)(wid * QBLK) * a.ldo); const unsigned offO = (unsigned)((lane >> 4) * a.ldo + (lane & 15) * 8) * 2u; const size_t rO = (size_t)a.ldo * 8;
#pragma unroll
      for (int i = 0; i < 8; ++i) { const int row = i * 4 + (lane >> 4), ch = lane & 15; const u32x4 v = *(const ATT_LAS u32x4*)(stg + row * 128 + ch * 8); *(u32x4*)(Ow + i * rO + offO) = v; } }
#endif
    }
    asm volatile("s_waitcnt vmcnt(0) lgkmcnt(0)" ::: "memory"); __builtin_amdgcn_s_barrier(); asm volatile("" ::: "memory");
#undef DMA16
#undef ISSUE_K
#undef ISSUE_V
#undef WAIT_TILE
#undef RESC
#undef TILE
}
#undef SBAR
}
constexpr int NWAVES = 8;
constexpr int DM = 2048, NB = 8, SEQL = 2048, CTXL = 256, SROW = SEQL + CTXL  , MT = NB * SROW  , DFF = 5632, NMODC = 9 * DM  ;
constexpr int HYB_IN = 4608, MLA_DP = 1536  , MLA_QW = 3072, MLA_KVW = 4096;
constexpr float EPS = 1e-6f;
#ifndef IMG_H
#define IMG_H 1
#endif
constexpr int IMG_NAT = IMG_H ? 16 : 0, IMG_PERM = IMG_H ? 32 : 0;
#ifndef HIN_DEFER
#define HIN_DEFER 0
#endif
#ifndef ATT_DMA
#define ATT_DMA 0
#endif
#ifndef ATT_STAG
#define ATT_STAG 1
#endif
#ifndef DOWN_KREV
#define DOWN_KREV 0
#endif
#ifndef MK_PER_PHASE
#define MK_PER_PHASE 0
#endif

constexpr size_t MiB = 1u << 20;
constexpr size_t WS_CTL = 0, CTL_ZERO_BYTES = 32768;
constexpr size_t WS_MODV = 1 * MiB;
constexpr size_t WS_ROPE = 3 * MiB;
constexpr size_t WS_W = 5 * MiB;
constexpr size_t SZ_WGU = (size_t)2 * DFF * DM * 2, SZ_WD = (size_t)DM * DFF * 2;
constexpr size_t WS_WGU = WS_W;
constexpr size_t WS_WD = WS_WGU + 4 * SZ_WGU;
constexpr size_t WS_WHIN = WS_WD + 4 * SZ_WD;
constexpr size_t WS_WHOUT = WS_WHIN + (size_t)HYB_IN * DM * 2;
constexpr size_t WS_WMDOWN = WS_WHOUT + (size_t)DM * DM * 2;
constexpr size_t WS_WMUQ = WS_WMDOWN + (size_t)MLA_DP * DM * 2;
constexpr size_t WS_WMUKV = WS_WMUQ + (size_t)MLA_QW * 768 * 2;
constexpr size_t WS_WMO = WS_WMUKV + (size_t)MLA_KVW * 512 * 2;
constexpr size_t WS_WEND = WS_WMO + (size_t)DM * DM * 2;
constexpr size_t WS_X = 318 * MiB;
constexpr size_t WS_XN = WS_X + (size_t)MT * DM * 4;
constexpr size_t WS_H = WS_XN + (size_t)MT * DM * 2;
#ifndef KV_PAD
#define KV_PAD 0
#endif
constexpr size_t WS_CD = (KV_PAD && XH) ? WS_X + (size_t)MT * DM * 2   : WS_H + (size_t)MT * MLA_KVW * 2;
constexpr size_t WS_Q2 = WS_H + (size_t)MT * DFF * 2;
constexpr size_t WS_END = WS_Q2 + (size_t)MT * MLA_QW * 2;
#ifndef BATCH_LOCAL
#define BATCH_LOCAL 0
#endif
constexpr int U_LD = BATCH_LOCAL ? DFF : HYB_IN, KV_LD = BATCH_LOCAL ? DFF : MLA_KVW + ((KV_PAD && XH) ? KV_PAD : 0), CD_LD = BATCH_LOCAL ? DFF : MLA_DP;
constexpr size_t WS_P = BATCH_LOCAL ? WS_END + 16 * MiB : WS_Q2;
constexpr size_t WS_AO = HIN_DEFER ? WS_END + 16 * MiB : WS_XN;
constexpr size_t WS_TOTAL = WS_END + 16 * MiB + (HIN_DEFER ? (size_t)MT * DM * 2 : 0) + (BATCH_LOCAL ? 64 * MiB : 0);
static_assert(!(HIN_DEFER && BATCH_LOCAL), "pick one");
static_assert(WS_WEND <= WS_X, "weights fit below X");
static_assert((KV_PAD && XH) ? (WS_CD + (size_t)MT * MLA_DP * 2 <= WS_XN && (size_t)MT * KV_LD * 2 <= (size_t)MT * DFF * 2) : (WS_CD + (size_t)MT * MLA_DP * 2 <= WS_Q2), "KV inside the H region, CD inside the H region or the free half of the X region");
constexpr int CW_BAR = 4096;

#ifndef LDS_BIG
#define LDS_BIG 0
#endif
constexpr int RING_OFF = 0, RING_BYTES = LDS_BIG ? 158720 : 131072;
constexpr int LDSCTL_OFF = RING_BYTES, MISC_OFF = LDSCTL_OFF + 320;
constexpr int LDS_BYTES = LDS_BIG ? 159744 : 147456;
static_assert(MISC_OFF + 128 <= LDS_BYTES, "LDS map");

#define GAS __attribute__((address_space(1)))
#define LAS __attribute__((address_space(3)))
typedef unsigned short bf16;
typedef unsigned v4u __attribute__((ext_vector_type(4)));
typedef unsigned v2u __attribute__((ext_vector_type(2)));
typedef float f32x4 __attribute__((ext_vector_type(4)));
typedef GAS unsigned gu32;
#define RLX_AGENT __ATOMIC_RELAXED, __HIP_MEMORY_SCOPE_AGENT
#define LDS_WAIT() asm volatile("s_waitcnt lgkmcnt(0)" ::: "memory")
#define VM_WAIT() asm volatile("s_waitcnt vmcnt(0)" ::: "memory")
__device__ __forceinline__ unsigned pk2(float lo, float hi) { unsigned r; asm volatile("v_cvt_pk_bf16_f32 %0, %1, %2" : "=v"(r) : "v"(lo), "v"(hi)); return r; }
__device__ __forceinline__ float bflo(unsigned w) { return __uint_as_float(w << 16); }
__device__ __forceinline__ float bfhi(unsigned w) { return __uint_as_float(w & 0xffff0000u); }
__device__ __forceinline__ void unpack8(const v4u w, float (&y)[8]) { y[0] = bflo(w.x); y[1] = bfhi(w.x); y[2] = bflo(w.y); y[3] = bfhi(w.y); y[4] = bflo(w.z); y[5] = bfhi(w.z); y[6] = bflo(w.w); y[7] = bfhi(w.w); }
__device__ __forceinline__ v4u pack8(const float (&y)[8]) { v4u w; w.x = pk2(y[0], y[1]); w.y = pk2(y[2], y[3]); w.z = pk2(y[4], y[5]); w.w = pk2(y[6], y[7]); return w; }

#ifndef BAR_EARLY_REL
#define BAR_EARLY_REL 0
#endif
#ifndef BAR_WG_REL
#define BAR_WG_REL 0
#endif
#define XB_TMO      128
#define XB_XCNT(j)  (256  + 64 * (j))
#define XB_XSUB(j)  (1280 + 64 * (j))
#define XB_XGEN(j)  (2304 + 64 * (j))
#define XB_TOP      3328
#define XB_TOPGEN   3392
#define XCD_BAR_WORDS 3456
#define XB_SPIN_CAP (1u << 20)

__device__ __forceinline__ unsigned xb_ld(unsigned* p)              { return __hip_atomic_load(p, __ATOMIC_RELAXED, __HIP_MEMORY_SCOPE_AGENT); }
__device__ __forceinline__ unsigned xb_add(unsigned* p, unsigned v) { return __hip_atomic_fetch_add(p, v, __ATOMIC_RELAXED, __HIP_MEMORY_SCOPE_AGENT); }
__device__ __forceinline__ unsigned xb_xcc_id() { return (unsigned)__builtin_amdgcn_s_getreg((3 << 11) | 20) & 0xFu; }
#define XB_SPIN(cond, bar) do { unsigned _sp = 0; while (cond) { __builtin_amdgcn_s_sleep(1); \
    if ((++_sp & 255u) == 0u) { if (xb_ld(&(bar)[XB_TMO])) break; if (_sp > XB_SPIN_CAP) { atomicAdd(&(bar)[XB_TMO], 1u); break; } } } } while (0)

struct XcdBarrier {
    unsigned* bar; unsigned x;
    volatile LAS unsigned* st;
};
__device__ __forceinline__ XcdBarrier xcd_barrier_post(unsigned* bar, volatile LAS unsigned* st, bool leader  ) {
    XcdBarrier b; b.bar = bar; b.x = xb_xcc_id(); b.st = st;
    if (leader) (void)xb_add(&bar[XB_XCNT(b.x)], 1u);
    return b;
}
__device__ __forceinline__ void xcd_barrier_complete(unsigned* bar, unsigned x, unsigned& nloc, unsigned& nx) {
    const unsigned G = gridDim.x * gridDim.y * gridDim.z;
    unsigned sum, cnt, mine, sp = 0u;
    for (;;) {
        sum = 0u; cnt = 0u; mine = 0u;
#pragma unroll
        for (unsigned j = 0; j < 16; ++j) { const unsigned c = xb_ld(&bar[XB_XCNT(j)]); sum += c; cnt += (c > 0u) ? 1u : 0u; mine = (j == x) ? c : mine; }
        if (sum == G) break;
        __builtin_amdgcn_s_sleep(1);
        if ((++sp & 255u) == 0u) { if (xb_ld(&bar[XB_TMO])) break; if (sp > XB_SPIN_CAP) { atomicAdd(&bar[XB_TMO], 1u); break; } }
    }
    nloc = mine > 0u ? mine : 1u; nx = cnt > 0u ? cnt : 1u;
}
__device__ __forceinline__ void xcd_barrier(const XcdBarrier& b, bool leader  ) {
    asm volatile("s_waitcnt vmcnt(0)" ::: "memory");
    __syncthreads();
    if (leader) {
        unsigned* bar = b.bar;
        __builtin_amdgcn_s_waitcnt(0);
        unsigned nloc = b.st[0], nx = b.st[1];
        if (nloc == 0u) { xcd_barrier_complete(bar, b.x, nloc, nx); b.st[0] = nloc; b.st[1] = nx; }
#if BAR_WG_REL
        __builtin_amdgcn_fence(__ATOMIC_RELEASE, "agent");
        asm volatile("s_waitcnt vmcnt(0)" ::: "memory");
#endif
        const unsigned old = xb_add(&bar[XB_XSUB(b.x)], 1u);
        const unsigned gen = old / nloc;
        if (old + 1u == (gen + 1u) * nloc) {
#if !BAR_WG_REL
            __builtin_amdgcn_fence(__ATOMIC_RELEASE, "agent");
            asm volatile("s_waitcnt vmcnt(0)" ::: "memory");
#endif
            const unsigned og = xb_add(&bar[XB_TOP], 1u);
            const unsigned tg = og / nx;
            if (og + 1u == (tg + 1u) * nx) xb_add(&bar[XB_TOPGEN], 1u);
            else XB_SPIN(xb_ld(&bar[XB_TOPGEN]) == tg, bar);
#if BAR_EARLY_REL
            asm volatile("" ::: "memory");
            xb_add(&bar[XB_XGEN(b.x)], 1u);
            __builtin_amdgcn_fence(__ATOMIC_ACQUIRE, "agent");
            asm volatile("s_waitcnt vmcnt(0)" ::: "memory");
#else
            __builtin_amdgcn_fence(__ATOMIC_ACQUIRE, "agent");
            xb_add(&bar[XB_XGEN(b.x)], 1u);
            asm volatile("s_waitcnt vmcnt(0)" ::: "memory");
#endif
        } else {
            XB_SPIN(xb_ld(&bar[XB_XGEN(b.x)]) == gen, bar);
            __builtin_amdgcn_fence(__ATOMIC_ACQUIRE, "agent");
            asm volatile("s_waitcnt vmcnt(0)" ::: "memory");
        }
    }
    __syncthreads();
}

__device__ __forceinline__ void xcd_barrier_local(const XcdBarrier& b, bool leader) {
    asm volatile("s_waitcnt vmcnt(0)" ::: "memory");
    __syncthreads();
    if (leader) {
        unsigned* bar = b.bar;
        __builtin_amdgcn_s_waitcnt(0);
        unsigned nloc = b.st[0], nx = b.st[1];
        if (nloc == 0u) { xcd_barrier_complete(bar, b.x, nloc, nx); b.st[0] = nloc; b.st[1] = nx; }
        const unsigned old = xb_add(&bar[XB_XSUB(b.x)], 1u);
        const unsigned gen = old / nloc;
        if (old + 1u == (gen + 1u) * nloc) { xb_add(&bar[XB_XGEN(b.x)], 1u); }
        else XB_SPIN(xb_ld(&bar[XB_XGEN(b.x)]) == gen, bar);
        __builtin_amdgcn_fence(__ATOMIC_ACQUIRE, "agent");
        asm volatile("s_waitcnt vmcnt(0)" ::: "memory");
    }
    __syncthreads();
}
struct Args { const float* in[27]; float* out; unsigned char* ws; int ph_lo, ph_hi; };
struct Frame {
    LAS unsigned char* lds;
    volatile LAS unsigned* MISC;
    int wave, vcu, G;
    unsigned char* ws;
};
__device__ __forceinline__ float wave_sum(float v) {
#pragma unroll
    for (int o = 1; o < 64; o <<= 1) v += __shfl_xor(v, o);
    return v;
}

#ifndef P0_NT
#define P0_NT 0
#endif
#ifndef P0_LD16
#define P0_LD16 0
#endif
__device__ __forceinline__ void p0_transpose_item(const float* W, int N, bf16* WT, int dK, int k0, int n0, int drow0, LAS float* scr, int lane, int img  ) {
#if P0_LD16
    f32x4 t_[8];
    const float* wp = W + (size_t)(k0 + (lane >> 3)) * N + n0 + (lane & 7) * 4;
#pragma unroll
    for (int i = 0; i < 8; ++i) t_[i] = *(const f32x4*)(wp + (size_t)(8 * i) * N);
#pragma unroll
    for (int i = 0; i < 8; ++i) { LAS float* d = scr + (8 * i + (lane >> 3)) * 33 + (lane & 7) * 4; d[0] = t_[i].x; d[1] = t_[i].y; d[2] = t_[i].z; d[3] = t_[i].w; }
#else
    float t_[32];
    const float* wp = W + (size_t)(k0 + (lane >> 5)) * N + n0 + (lane & 31);
#pragma unroll
    for (int i = 0; i < 32; ++i) t_[i] = P0_NT ? __builtin_nontemporal_load(wp + (size_t)(2 * i) * N) : wp[(size_t)(2 * i) * N];
#pragma unroll
    for (int i = 0; i < 32; ++i) scr[(2 * i + (lane >> 5)) * 33 + (lane & 31)] = t_[i];
#endif
    LDS_WAIT(); asm volatile("" ::: "memory");
    const int c = lane & 7;
#pragma unroll
    for (int j = 0; j < 4; ++j) { const int n = (lane >> 3) + 8 * j; const LAS float* s = scr + (8 * c) * 33 + n;
        v4u o; o.x = pk2(s[0 * 33], s[1 * 33]); o.y = pk2(s[2 * 33], s[3 * 33]); o.z = pk2(s[4 * 33], s[5 * 33]); o.w = pk2(s[6 * 33], s[7 * 33]);
        const int dr = drow0 + n;
        if (img == 0) *(v4u*)(WT + (size_t)dr * dK + k0 + 8 * c) = o;
        else *(v4u*)((char*)WT + pg8::img_off(img == 3 ? pg8::img_row_perm_adj(dr) : (img == 2 ? pg8::img_row_perm(dr) : dr), k0 + 8 * c, dK)) = o; }
    LDS_WAIT(); asm volatile("" ::: "memory");
}
#ifndef RES_PERM
#define RES_PERM 2
#endif
static_assert(RES_PERM != 2 || IMG_H, "adjacent column halves need the image-layout weight copies");
#define IMG_RES (RES_PERM == 2 ? (IMG_H ? 48 : 0) : (RES_PERM ? IMG_PERM : IMG_NAT))
struct WDesc { int in_idx, src_off, K, N, mode; unsigned dst_mib2; int items; };
#define WD_FFN(l, f) {9 + 3 * (f) + 0, (l) * DM * DFF, DM, DFF, 1 + IMG_PERM, (unsigned)((WS_WGU + ((l) * 2 + (f)) * SZ_WGU) / (MiB / 2)), (DM / 64) * (DFF / 32)}, \
                     {9 + 3 * (f) + 1, (l) * DM * DFF, DM, DFF, 2 + IMG_PERM, (unsigned)((WS_WGU + ((l) * 2 + (f)) * SZ_WGU) / (MiB / 2)), (DM / 64) * (DFF / 32)}, \
                     {9 + 3 * (f) + 2, (l) * DM * DFF, DFF, DM, IMG_RES, (unsigned)((WS_WD + ((l) * 2 + (f)) * SZ_WD) / (MiB / 2)), (DFF / 64) * (DM / 32)}
__constant__ WDesc g_wdesc[18] = {
    WD_FFN(0, 0), WD_FFN(0, 1), WD_FFN(1, 0), WD_FFN(1, 1),
    {15, 0, DM, HYB_IN, IMG_PERM, (unsigned)(WS_WHIN / (MiB / 2)), (DM / 64) * (HYB_IN / 32)},
    {19, 0, DM, DM, IMG_RES, (unsigned)(WS_WHOUT / (MiB / 2)), (DM / 64) * (DM / 32)},
    {20, 0, DM, 1344, IMG_PERM, (unsigned)(WS_WMDOWN / (MiB / 2)), (DM / 64) * (1344 / 32)},
    {23, 0, 768, MLA_QW, IMG_PERM, (unsigned)(WS_WMUQ / (MiB / 2)), (768 / 64) * (MLA_QW / 32)},
    {24, 0, 512, MLA_KVW, IMG_PERM, (unsigned)(WS_WMUKV / (MiB / 2)), (512 / 64) * (MLA_KVW / 32)},
    {25, 0, DM, DM, IMG_RES, (unsigned)(WS_WMO / (MiB / 2)), (DM / 64) * (DM / 32)},
};
static_assert(WS_WGU % (MiB / 2) == 0 && SZ_WGU % (MiB / 2) == 0 && WS_WD % (MiB / 2) == 0 && SZ_WD % (MiB / 2) == 0 && WS_WHIN % (MiB / 2) == 0 && WS_WHOUT % (MiB / 2) == 0 && WS_WMDOWN % (MiB / 2) == 0 &&
              WS_WMUQ % (MiB / 2) == 0 && WS_WMUKV % (MiB / 2) == 0 && WS_WMO % (MiB / 2) == 0, "weight copies on half-MiB boundaries");
__device__ __forceinline__ void bg_transposes(Frame& F, const Args& args, int d0, int d1, int rank, int nranks, int it_lo = 0, int it_hi = 1 << 30) {
    FRESH_LANE(lane);
    LAS float* scr = (LAS float*)(F.lds + RING_OFF + F.wave * 16384);
    int total = 0;
#pragma unroll 1
    for (int j = d0; j < d1; ++j) total += g_wdesc[j].items;
    if (it_hi < total) total = it_hi;
    for (int it = it_lo + rank; it < total; it += nranks) {
        int r = it, j = d0;
#pragma unroll 1
        while (r >= g_wdesc[j].items) { r -= g_wdesc[j].items; ++j; }
        const WDesc d = g_wdesc[j];
        const int nblk = d.N / 32, kb = r / nblk, nb = r - kb * nblk, n0 = 32 * nb;
        const int rm = d.mode & 3, drow0 = rm == 0 ? n0 : ((n0 >> 7) * 256 + (rm == 2 ? 128 : 0) + (n0 & 127));
        p0_transpose_item(args.in[d.in_idx] + (size_t)d.src_off, d.N, (bf16*)(F.ws + (size_t)d.dst_mib2 * (MiB / 2)), d.K, 64 * kb, n0, drow0, scr, lane, d.mode >> 4);
    }
}
constexpr int MG_NB = 576, MG_NBLK = NMODC / MG_NB  , MG_KB = 256, MG_KBLK = DM / MG_KB  ;
constexpr size_t WS_MPART = WS_END;
__device__ __forceinline__ void mod_gemv_partial(Frame& F, const Args& args, int layer, int rank, int nranks) {
    FRESH_LANE(lane); const int tid = F.wave * 64 + lane;
    LAS float* st = (LAS float*)(F.lds + RING_OFF);
    LAS float* part = (LAS float*)(F.lds + RING_OFF + 73728);
    const float* cin = args.in[1]; const float* cctx = args.in[3]; const float* mw = args.in[4];
    float* PART = (float*)(F.ws + WS_MPART) + (size_t)layer * MG_KBLK * 9 * NMODC;
    if (rank >= MG_KBLK * MG_NBLK) return;
    for (int i = tid; i < 9 * DM; i += NWAVES * 64) { const int r = i >> 11, k = i & 2047; const float v = r < 8 ? cin[r * DM + k] : cctx[k]; st[i] = v / (1.0f + expf(-v)); }
    __syncthreads();
    for (int item = rank; item < MG_KBLK * MG_NBLK; item += nranks) {
        const int kblk = item / MG_NBLK, nblk = item - kblk * MG_NBLK, n0 = nblk * MG_NB, k0 = kblk * MG_KB + F.wave * 32;
        const float* W = mw + (size_t)layer * DM * NMODC + (size_t)k0 * NMODC + n0 + lane * 4;
        f32x4 acc[3][9];
#pragma unroll
        for (int g = 0; g < 3; ++g)
#pragma unroll
            for (int r = 0; r < 9; ++r) acc[g][r] = (f32x4){0.f, 0.f, 0.f, 0.f};
#pragma unroll 4
        for (int i = 0; i < 32; ++i) {
            const float* wr_ = W + (size_t)i * NMODC;
            const f32x4 w0 = P0_NT ? __builtin_nontemporal_load((const f32x4*)(wr_)) : *(const f32x4*)(wr_), w1 = P0_NT ? __builtin_nontemporal_load((const f32x4*)(wr_ + 256)) : *(const f32x4*)(wr_ + 256);
            f32x4 w2 = (f32x4){0.f, 0.f, 0.f, 0.f}; if (lane < 16) w2 = P0_NT ? __builtin_nontemporal_load((const f32x4*)(wr_ + 512)) : *(const f32x4*)(wr_ + 512);
#pragma unroll
            for (int r = 0; r < 9; ++r) { const float sv = st[r * DM + k0 + i]; acc[0][r] += sv * w0; acc[1][r] += sv * w1; acc[2][r] += sv * w2; }
        }
#pragma unroll
        for (int r = 0; r < 9; ++r) {
            const f32x4 a0 = acc[0][r], a1 = acc[1][r], a2 = acc[2][r];
            *(LAS f32x4*)(part + F.wave * MG_NB + lane * 4) = a0; *(LAS f32x4*)(part + F.wave * MG_NB + 256 + lane * 4) = a1; if (lane < 16) *(LAS f32x4*)(part + F.wave * MG_NB + 512 + lane * 4) = a2;
            __syncthreads();
            for (int c = tid; c < MG_NB; c += NWAVES * 64) { float s = 0.f;
#pragma unroll
                for (int w = 0; w < 8; ++w) s += part[w * MG_NB + c];
                PART[((size_t)kblk * 9 + r) * NMODC + n0 + c] = s; }
            __syncthreads();
        }
    }
}
__device__ __forceinline__ void mod_gemv_reduce(Frame& F, const Args& args, int layer, int rank_t, int nranks_t) {
    const float* mb = args.in[5]; const float* PART = (const float*)(F.ws + WS_MPART) + (size_t)layer * MG_KBLK * 9 * NMODC; float* MODV = (float*)(F.ws + WS_MODV);
    for (int i = rank_t; i < 9 * NMODC / 4; i += nranks_t) { const int r = i / (NMODC / 4), c4 = i - r * (NMODC / 4);
        f32x4 s = *(const f32x4*)(mb + (size_t)layer * NMODC + c4 * 4);
#pragma unroll
        for (int kb = 0; kb < MG_KBLK; ++kb) s += *(const f32x4*)(PART + ((size_t)kb * 9 + r) * NMODC + c4 * 4);
        *(f32x4*)(MODV + (size_t)(layer * 9 + r) * NMODC + c4 * 4) = s; }
}
__device__ __forceinline__ void p0_prologue(Frame& F, const Args& args) {
    FRESH_LANE(lane); const int tid = F.wave * 64 + lane; (void)tid;
    const int gw = F.vcu * NWAVES + F.wave, NGW = F.G * NWAVES, gt = gw * 64 + lane, NGT = NGW * 64;
    {
        bg_transposes(F, args, 0, 18, gw, NGW);
        for (int i = gt; i < (MLA_DP - 1344) * (DM / 8); i += NGT) { const int n = 1344 + i / (DM / 8), k = (i % (DM / 8)) * 8;
            char* zb = (char*)(F.ws + WS_WMDOWN);
            *(v4u*)(IMG_H ? zb + pg8::img_off(pg8::img_row_perm(n), k, DM) : zb + ((size_t)n * DM + k) * 2) = (v4u){0u, 0u, 0u, 0u}; }
    }
    {
        float* cosA = (float*)(F.ws + WS_ROPE); float* sinA = cosA + SEQL * 64; float* cosM = sinA + SEQL * 64; float* sinM = cosM + SEQL * 32;
        for (int i = gt; i < SEQL * 96; i += NGT) {
            const int t = i / 96, e = i - t * 96; const bool isA = e < 64; const int p = isA ? e : e - 64, hp = isA ? 32 : 16;
            const int fi = p < hp ? p : p - hp; const float pos = (float)(p < hp ? (t >> 6) : (t & 63));
            const float inv = 1.0f / powf(10000.0f, (float)(2 * fi) / (float)(2 * hp));
            const float ang = pos * inv;
            if (isA) { cosA[t * 64 + p] = cosf(ang); sinA[t * 64 + p] = sinf(ang); } else { cosM[t * 32 + p] = cosf(ang); sinM[t * 32 + p] = sinf(ang); }
        }
    }
    __syncthreads();
    mod_gemv_partial(F, args, 0, (int)blockIdx.x, F.G);
    mod_gemv_partial(F, args, 1, (int)blockIdx.x, F.G);
}

__device__ __forceinline__ bool np_rowinfo(int k, int gw, int cpw, int lpw, int& b, int& s) {
    if (k < cpw) { const int cr = gw * cpw + k; if (cr >= NB * CTXL) return false; b = cr / CTXL; s = cr - b * CTXL; }
    else { const int lr = gw * lpw + (k - cpw); if (lr >= NB * SEQL) return false; b = lr / SEQL; s = CTXL + lr - b * SEQL; }
    return true;
}
#ifndef OUT_NT
#define OUT_NT 0
#endif
#ifndef XN_NT
#define XN_NT 0
#endif
#ifndef NORM16
#define NORM16 1
#endif
#if NORM16
#define NCOL(jj, l) (((jj) >> 1) * 512 + (l) * 8 + ((jj) & 1) * 4)
#else
#define NCOL(jj, l) ((jj) * 256 + (l) * 4)
#endif
__device__ __forceinline__ void np_ldx(const xres_t* rowp, int lane, f32x4 (&v)[8]) {
#if NORM16
#pragma unroll
    for (int j = 0; j < 4; ++j) xres_ld8(rowp + j * 512 + lane * 8, v[2 * j], v[2 * j + 1]);
#else
#pragma unroll
    for (int j = 0; j < 8; ++j) v[j] = xres_ld4(rowp + j * 256 + lane * 4);
#endif
}
__device__ __forceinline__ void np_stx(xres_t* rowp, int lane, const f32x4 (&v)[8]) {
#if NORM16
#pragma unroll
    for (int j = 0; j < 4; ++j) xres_st8(rowp + j * 512 + lane * 8, v[2 * j], v[2 * j + 1]);
#else
#pragma unroll
    for (int j = 0; j < 8; ++j) xres_st4(rowp + j * 256 + lane * 4, v[j]);
#endif
}
__device__ __forceinline__ void norm_phase(Frame& F, const float* gain, const float* modL, int shift_chunk, int scale_chunk, bool lat_only, bool pend, const float* xin, const float* cin, bool rm_probe = false) {
    FRESH_LANE(lane);
    const int gw = F.vcu * NWAVES + F.wave, NGW = F.G * NWAVES;
    const int cpw = (NB * CTXL + NGW - 1) / NGW, lpw = (NB * SEQL + NGW - 1) / NGW;
    xres_t* X = (xres_t*)(F.ws + WS_X); bf16* XN = (bf16*)(F.ws + WS_XN);
    f32x4 A[8], B[8]; int cur_r = -1;
    const int k0 = lat_only ? cpw : 0, k1 = cpw + lpw;
    int bn = 0, sn = 0; bool okn = (k0 < k1) && np_rowinfo(k0, gw, cpw, lpw, bn, sn); bool f32n = false;
    f32x4 vn[8];
#if XH
#if NORM16
    xh8_t hn[4];
#define NP_ISSUE_X() do { const xres_t* xs = X + (size_t)(bn * SROW + sn) * DM + lane * 8; _Pragma("unroll") for (int j = 0; j < 4; ++j) hn[j] = *(const xh8_t*)(xs + j * 512); } while (0)
#define NP_TAKE_X() do { _Pragma("unroll") for (int j = 0; j < 4; ++j) { const xf8_t t = __builtin_convertvector(hn[j], xf8_t); v[2 * j] = (f32x4){t[0], t[1], t[2], t[3]}; v[2 * j + 1] = (f32x4){t[4], t[5], t[6], t[7]}; } } while (0)
#else
    xh4_t hn[8];
#define NP_ISSUE_X() do { const xres_t* xs = X + (size_t)(bn * SROW + sn) * DM + lane * 4; _Pragma("unroll") for (int j = 0; j < 8; ++j) hn[j] = *(const xh4_t*)(xs + j * 256); } while (0)
#define NP_TAKE_X() do { _Pragma("unroll") for (int j = 0; j < 8; ++j) v[j] = __builtin_convertvector(hn[j], f32x4); } while (0)
#endif
#define NP_ISSUE() do { const float* in_ = sn < CTXL ? cin : xin; f32n = in_ != nullptr; \
        if (f32n) { const float* xs = in_ + (size_t)(sn < CTXL ? bn * CTXL + sn : bn * SEQL + sn - CTXL) * DM; _Pragma("unroll") for (int j = 0; j < 8; ++j) vn[j] = *(const f32x4*)(xs + NCOL(j, lane)); } \
        else NP_ISSUE_X(); } while (0)
#else
#define NP_ISSUE() do { const float* in_ = sn < CTXL ? cin : xin; f32n = true; \
        const float* xs = in_ ? in_ + (size_t)(sn < CTXL ? bn * CTXL + sn : bn * SEQL + sn - CTXL) * DM : X + (size_t)(bn * SROW + sn) * DM; \
        _Pragma("unroll") for (int j = 0; j < 8; ++j) vn[j] = *(const f32x4*)(xs + NCOL(j, lane)); } while (0)
#endif
    if (okn) NP_ISSUE();
    for (int k = k0; k < k1; ++k) {
        const bool ok = okn; const int b = bn, s = sn;
        f32x4 v[8];
#if XH
        if (f32n) {
#pragma unroll
            for (int j = 0; j < 8; ++j) v[j] = vn[j];
        } else NP_TAKE_X();
#else
#pragma unroll
        for (int j = 0; j < 8; ++j) v[j] = vn[j];
#endif
        okn = (k + 1 < k1) && np_rowinfo(k + 1, gw, cpw, lpw, bn, sn);
        if (okn) NP_ISSUE();
        if (!ok) continue;
        const int row = b * SROW + s, r = s < CTXL ? 8 : b;
        if (r != cur_r) { cur_r = r;
            const float* sc = modL + (size_t)r * NMODC + scale_chunk * DM; const float* sh = modL + (size_t)r * NMODC + shift_chunk * DM;
#pragma unroll
            for (int j = 0; j < 8; ++j) { const f32x4 g = *(const f32x4*)(gain + NCOL(j, lane)), s4 = *(const f32x4*)(sc + NCOL(j, lane));
                A[j] = g * (1.0f + s4); B[j] = *(const f32x4*)(sh + NCOL(j, lane)); } }
        float ss = 0.f;
        if (pend && s < CTXL) {
            const xres_t* pr = (const xres_t*)(F.ws + WS_P) + (size_t)(b * CTXL + s) * DM;
#pragma unroll
            for (int q = 0; q < 4; ++q) { f32x4 t[8]; np_ldx(pr + (size_t)q * (NB * CTXL) * DM, lane, t);
#pragma unroll
                for (int j = 0; j < 8; ++j) v[j] += t[j]; }
            np_stx(X + (size_t)row * DM, lane, v);
        }
#pragma unroll
        for (int j = 0; j < 8; ++j) ss += (v[j].x * v[j].x + v[j].y * v[j].y) + (v[j].z * v[j].z + v[j].w * v[j].w);
        const float rstd = 1.0f / sqrtf(wave_sum(ss) * (1.0f / DM) + EPS);
#if NORM16
#pragma unroll
        for (int j = 0; j < 4; ++j) { const f32x4 y0 = v[2 * j] * rstd * A[2 * j] + B[2 * j], y1 = v[2 * j + 1] * rstd * A[2 * j + 1] + B[2 * j + 1];
            v4u w; w.x = pk2(y0.x, y0.y); w.y = pk2(y0.z, y0.w); w.z = pk2(y1.x, y1.y); w.w = pk2(y1.z, y1.w);
            if (rm_probe) *(v4u*)((bf16*)(F.ws + WS_TOTAL + 16 * MiB) + (size_t)row * DM + j * 512 + lane * 8) = w; else
            if (IMG_H) { if (XN_NT) __builtin_nontemporal_store(w, (v4u*)((char*)XN + pg8::img_off(row, j * 512 + lane * 8, DM))); else *(v4u*)((char*)XN + pg8::img_off(row, j * 512 + lane * 8, DM)) = w; } else *(v4u*)(XN + (size_t)row * DM + j * 512 + lane * 8) = w; }
#else
#pragma unroll
        for (int j = 0; j < 8; ++j) { const f32x4 y = v[j] * rstd * A[j] + B[j]; v2u w; w.x = pk2(y.x, y.y); w.y = pk2(y.z, y.w);
            if (IMG_H) *(v2u*)((char*)XN + pg8::img_off(row, j * 256 + lane * 4, DM)) = w; else *((v2u*)(XN + (size_t)row * DM) + lane + 64 * j) = w; }
#endif
    }
#undef NP_ISSUE
#if XH
#undef NP_ISSUE_X
#undef NP_TAKE_X
#endif
}
#if XH && NORM16
#ifndef NORM_D2
#define NORM_D2 0
#endif
__device__ __forceinline__ void norm_phase_d2(Frame& F, const float* gain, const float* modL, int shift_chunk, int scale_chunk, bool lat_only, bool pend, const float* cin) {
    FRESH_LANE(lane);
    const int gw = F.vcu * NWAVES + F.wave, NGW = F.G * NWAVES;
    const int cpw = (NB * CTXL + NGW - 1) / NGW, lpw = (NB * SEQL + NGW - 1) / NGW;
    xres_t* X = (xres_t*)(F.ws + WS_X); bf16* XN = (bf16*)(F.ws + WS_XN);
    f32x4 A[8], B[8]; int cur_r = -1;
    const int k0 = lat_only ? cpw : 0, k1 = cpw + lpw;
    xh8_t h0[4], h1[4]; f32x4 vn[8];
    bool ok0 = false, ok1 = false, f0 = false, f1 = false; int b0 = 0, s0 = 0, b1 = 0, s1 = 0;
#define NP2_ISSUE(kk, H, OK, BB, SS, FF) do { OK = ((kk) < k1) && np_rowinfo((kk), gw, cpw, lpw, BB, SS); FF = false; \
        if (OK) { if (cin && SS < CTXL) { FF = true; const float* xs = cin + (size_t)(BB * CTXL + SS) * DM; _Pragma("unroll") for (int j = 0; j < 8; ++j) vn[j] = *(const f32x4*)(xs + NCOL(j, lane)); } \
                  else { const xres_t* xs = X + (size_t)(BB * SROW + SS) * DM + lane * 8; _Pragma("unroll") for (int j = 0; j < 4; ++j) H[j] = *(const xh8_t*)(xs + j * 512); } } } while (0)
#define NP2_ROW(kk, H, OK, BB, SS, FF) do { \
        const bool ok = OK; const int b = BB, s = SS; f32x4 v[8]; \
        if (FF) { _Pragma("unroll") for (int j = 0; j < 8; ++j) v[j] = vn[j]; } \
        else { _Pragma("unroll") for (int j = 0; j < 4; ++j) { const xf8_t t = __builtin_convertvector(H[j], xf8_t); v[2 * j] = (f32x4){t[0], t[1], t[2], t[3]}; v[2 * j + 1] = (f32x4){t[4], t[5], t[6], t[7]}; } } \
        NP2_ISSUE((kk) + 2, H, OK, BB, SS, FF); \
        if (ok) { \
            const int row = b * SROW + s, r = s < CTXL ? 8 : b; \
            if (r != cur_r) { cur_r = r; \
                const float* sc = modL + (size_t)r * NMODC + scale_chunk * DM; const float* sh = modL + (size_t)r * NMODC + shift_chunk * DM; \
                _Pragma("unroll") for (int j = 0; j < 8; ++j) { const f32x4 g = *(const f32x4*)(gain + NCOL(j, lane)), s4 = *(const f32x4*)(sc + NCOL(j, lane)); \
                    A[j] = g * (1.0f + s4); B[j] = *(const f32x4*)(sh + NCOL(j, lane)); } } \
            if (pend && s < CTXL) { \
                const xres_t* pr = (const xres_t*)(F.ws + WS_P) + (size_t)(b * CTXL + s) * DM; \
                _Pragma("unroll") for (int q = 0; q < 4; ++q) { f32x4 t[8]; np_ldx(pr + (size_t)q * (NB * CTXL) * DM, lane, t); \
                    _Pragma("unroll") for (int j = 0; j < 8; ++j) v[j] += t[j]; } \
                np_stx(X + (size_t)row * DM, lane, v); } \
            float ss = 0.f; \
            _Pragma("unroll") for (int j = 0; j < 8; ++j) ss += (v[j].x * v[j].x + v[j].y * v[j].y) + (v[j].z * v[j].z + v[j].w * v[j].w); \
            const float rstd = 1.0f / sqrtf(wave_sum(ss) * (1.0f / DM) + EPS); \
            _Pragma("unroll") for (int j = 0; j < 4; ++j) { const f32x4 y0 = v[2 * j] * rstd * A[2 * j] + B[2 * j], y1 = v[2 * j + 1] * rstd * A[2 * j + 1] + B[2 * j + 1]; \
                v4u w; w.x = pk2(y0.x, y0.y); w.y = pk2(y0.z, y0.w); w.z = pk2(y1.x, y1.y); w.w = pk2(y1.z, y1.w); \
                if (IMG_H) *(v4u*)((char*)XN + pg8::img_off(row, j * 512 + lane * 8, DM)) = w; else *(v4u*)(XN + (size_t)row * DM + j * 512 + lane * 8) = w; } } } while (0)
    NP2_ISSUE(k0, h0, ok0, b0, s0, f0);
    NP2_ISSUE(k0 + 1, h1, ok1, b1, s1, f1);
    for (int k = k0; k < k1; k += 2) {
        NP2_ROW(k, h0, ok0, b0, s0, f0);
        NP2_ROW(k + 1, h1, ok1, b1, s1, f1);
    }
#undef NP2_ISSUE
#undef NP2_ROW
}
#endif
#if XT
__device__ __forceinline__ void norm_band_phase(Frame& F, const float* gain, const float* modL, int shift_chunk, int scale_chunk, bool lat_only, bool pend, const float* cin) {
    FRESH_LANE(lane);
    const int fr = lane & 15, fq = lane >> 4, w = F.wave, tid = w * 64 + lane;
    const unsigned loff = (unsigned)((fr * 64 + fq * 16) ^ ((fr >> 3) << 5));
    char* Xb = (char*)(F.ws + WS_X); char* XNb = (char*)(F.ws + WS_XN); const char* Pb = (const char*)(F.ws + WS_P);
    LAS float* red = (LAS float*)(F.lds + RING_OFF); LAS float* ABl = (LAS float*)(F.lds + RING_OFF + 4096);
    const int nb = lat_only ? NB * 128 : NB * 144;
    const bool contig = F.G == 256;
    const int j0 = contig ? (F.vcu * nb) >> 8 : F.vcu, j1 = contig ? ((F.vcu + 1) * nb) >> 8 : nb, jstep = contig ? 1 : F.G;
#define NB_DEC(j_, b_, sb_) do { if (lat_only) { b_ = (j_) >> 7; sb_ = 16 + ((j_) & 127); } else { b_ = (j_) / 144; sb_ = (j_) - b_ * 144; } } while (0)
#define NB_BASE(b_, sb_) (((unsigned)((b_) * 18 + ((sb_) >> 3)) * 32u + 4u * (unsigned)w) * 16384u + (unsigned)((sb_) & 7) * 2048u + loff)
#define NB_IOFF(i_) ((unsigned)((i_) >> 1) * 16384u + (unsigned)((i_) & 1) * 1024u)
    int cur_r = -1, buf = 0;
    xh8_t hn[8]; bool hn_ok = false;
    if (j0 < j1) { int b_, sb_; NB_DEC(j0, b_, sb_); if (!(cin && sb_ < 16)) { const char* xs = Xb + NB_BASE(b_, sb_);
#pragma unroll
            for (int i = 0; i < 8; ++i) hn[i] = *(const xh8_t*)(xs + NB_IOFF(i)); hn_ok = true; } }
    for (int j = j0; j < j1; j += jstep) {
        int b, sb; NB_DEC(j, b, sb);
        const bool isctx = sb < 16; const int r = isctx ? 8 : b;
        const unsigned base = NB_BASE(b, sb);
        f32x4 v[16];
        if (hn_ok) {
#pragma unroll
            for (int i = 0; i < 8; ++i) { const xf8_t t = __builtin_convertvector(hn[i], xf8_t); v[2 * i] = (f32x4){t[0], t[1], t[2], t[3]}; v[2 * i + 1] = (f32x4){t[4], t[5], t[6], t[7]}; }
        } else {
            const float* cs = cin + (size_t)(b * CTXL + sb * 16 + fr) * DM + 256 * w + 8 * fq;
#pragma unroll
            for (int i = 0; i < 8; ++i) { v[2 * i] = *(const f32x4*)(cs + 32 * i); v[2 * i + 1] = *(const f32x4*)(cs + 32 * i + 4); }
        }
        hn_ok = false;
        if (j + jstep < j1) { int b_, sb_; NB_DEC(j + jstep, b_, sb_); if (!(cin && sb_ < 16)) { const char* xs = Xb + NB_BASE(b_, sb_);
#pragma unroll
                for (int i = 0; i < 8; ++i) hn[i] = *(const xh8_t*)(xs + NB_IOFF(i)); hn_ok = true; } }
        if (r != cur_r) { cur_r = r;
            const float* sc = modL + (size_t)r * NMODC + scale_chunk * DM; const float* sh = modL + (size_t)r * NMODC + shift_chunk * DM;
            __syncthreads();
            { const f32x4 g = *(const f32x4*)(gain + tid * 4), s4 = *(const f32x4*)(sc + tid * 4), h4 = *(const f32x4*)(sh + tid * 4);
              *(LAS f32x4*)(ABl + tid * 4) = g * (1.0f + s4); *(LAS f32x4*)(ABl + 2048 + tid * 4) = h4; }
            __syncthreads(); }
        if (pend && isctx) {
            const char* ps = Pb + (((unsigned)(b * 2 + (sb >> 3)) * 32u + 4u * (unsigned)w) * 16384u + (unsigned)(sb & 7) * 2048u + loff);
#pragma unroll
            for (int q = 0; q < 4; ++q)
#pragma unroll
                for (int i = 0; i < 8; ++i) { const xf8_t t = __builtin_convertvector(*(const xh8_t*)(ps + (size_t)q * (2048u * 4096u) + NB_IOFF(i)), xf8_t);
                    v[2 * i] += (f32x4){t[0], t[1], t[2], t[3]}; v[2 * i + 1] += (f32x4){t[4], t[5], t[6], t[7]}; }
#pragma unroll
            for (int i = 0; i < 8; ++i) { const xf8_t t = {v[2 * i][0], v[2 * i][1], v[2 * i][2], v[2 * i][3], v[2 * i + 1][0], v[2 * i + 1][1], v[2 * i + 1][2], v[2 * i + 1][3]};
                *(xh8_t*)(Xb + base + NB_IOFF(i)) = __builtin_convertvector(t, xh8_t); }
        }
        float ss = 0.f;
#pragma unroll
        for (int i = 0; i < 16; ++i) ss += (v[i].x * v[i].x + v[i].y * v[i].y) + (v[i].z * v[i].z + v[i].w * v[i].w);
        ss += __shfl_xor(ss, 16); ss += __shfl_xor(ss, 32);
        if (fq == 0) red[buf * 128 + w * 16 + fr] = ss;
        __syncthreads();
        float tot = 0.f;
#pragma unroll
        for (int k = 0; k < 8; ++k) tot += red[buf * 128 + k * 16 + fr];
        const float rstd = 1.0f / sqrtf(tot * (1.0f / DM) + EPS);
#pragma unroll
        for (int i = 0; i < 8; ++i) { const int c0 = 256 * w + 32 * i + 8 * fq;
            const f32x4 a0 = *(const LAS f32x4*)(ABl + c0), a1 = *(const LAS f32x4*)(ABl + c0 + 4), b0 = *(const LAS f32x4*)(ABl + 2048 + c0), b1 = *(const LAS f32x4*)(ABl + 2048 + c0 + 4);
            const f32x4 y0 = v[2 * i] * rstd * a0 + b0, y1 = v[2 * i + 1] * rstd * a1 + b1;
            v4u o; o.x = pk2(y0.x, y0.y); o.y = pk2(y0.z, y0.w); o.z = pk2(y1.x, y1.y); o.w = pk2(y1.z, y1.w);
            *(v4u*)(XNb + base + NB_IOFF(i)) = o; }
        buf ^= 1;
    }
    __syncthreads();
#undef NB_DEC
#undef NB_BASE
#undef NB_IOFF
}
#endif
__device__ __forceinline__ void final_norm_phase(Frame& F, const float* gain, float* out) {
    FRESH_LANE(lane);
    const int gw = F.vcu * NWAVES + F.wave, NGW = F.G * NWAVES;
    const xres_t* X = (const xres_t*)(F.ws + (XT ? WS_XN : WS_X));
    f32x4 A[8];
#pragma unroll
    for (int j = 0; j < 8; ++j) A[j] = *(const f32x4*)(gain + NCOL(j, lane));
#if XH && NORM16
    xh8_t vn[4];
#define FN_ISSUE(lr_) do { const xres_t* xr = X + (size_t)(((lr_) >> 11) * SROW + CTXL + ((lr_) & 2047)) * DM + lane * 8; _Pragma("unroll") for (int j = 0; j < 4; ++j) vn[j] = *(const xh8_t*)(xr + j * 512); } while (0)
#define FN_TAKE() do { _Pragma("unroll") for (int j = 0; j < 4; ++j) { const xf8_t t = __builtin_convertvector(vn[j], xf8_t); v[2 * j] = (f32x4){t[0], t[1], t[2], t[3]}; v[2 * j + 1] = (f32x4){t[4], t[5], t[6], t[7]}; } } while (0)
#elif XH
    xh4_t vn[8];
#define FN_ISSUE(lr_) do { const xres_t* xr = X + (size_t)(((lr_) >> 11) * SROW + CTXL + ((lr_) & 2047)) * DM + lane * 4; _Pragma("unroll") for (int j = 0; j < 8; ++j) vn[j] = *(const xh4_t*)(xr + j * 256); } while (0)
#define FN_TAKE() do { _Pragma("unroll") for (int j = 0; j < 8; ++j) v[j] = __builtin_convertvector(vn[j], f32x4); } while (0)
#else
    f32x4 vn[8];
#define FN_ISSUE(lr_) do { const xres_t* xr = X + (size_t)(((lr_) >> 11) * SROW + CTXL + ((lr_) & 2047)) * DM; _Pragma("unroll") for (int j = 0; j < 8; ++j) vn[j] = *(const f32x4*)(xr + NCOL(j, lane)); } while (0)
#define FN_TAKE() do { _Pragma("unroll") for (int j = 0; j < 8; ++j) v[j] = vn[j]; } while (0)
#endif
    if (gw < NB * SEQL) FN_ISSUE(gw);
    for (int lr = gw; lr < NB * SEQL; lr += NGW) {
        f32x4 v[8];
        FN_TAKE();
        const int ln = lr + NGW;
        if (ln < NB * SEQL) FN_ISSUE(ln);
        float ss = 0.f;
#pragma unroll
        for (int j = 0; j < 8; ++j) ss += (v[j].x * v[j].x + v[j].y * v[j].y) + (v[j].z * v[j].z + v[j].w * v[j].w);
        const float rstd = 1.0f / sqrtf(wave_sum(ss) * (1.0f / DM) + EPS);
        float* o = out + (size_t)lr * DM;
#pragma unroll
        for (int j = 0; j < 8; ++j) { if (OUT_NT) __builtin_nontemporal_store(v[j] * rstd * A[j], (f32x4*)(o + NCOL(j, lane))); else *(f32x4*)(o + NCOL(j, lane)) = v[j] * rstd * A[j]; }
    }
#undef FN_ISSUE
#undef FN_TAKE
}

#ifndef HYB_SLIDE
#define HYB_SLIDE 0
#endif
__device__ __forceinline__ void hyb_thin(Frame& F, const float* conv_w, const float* k_gain, const int gw, const int NGW, const int part = 3  ) {
    FRESH_LANE(lane); const int tid = F.wave * 64 + lane; (void)tid;

    bf16* U = (bf16*)(F.ws + WS_H); bf16* AO = (bf16*)(F.ws + WS_AO);
    const float* cosA = (const float*)(F.ws + WS_ROPE); const float* sinA = cosA + SEQL * 64;
    const bool blm = BATCH_LOCAL && F.G == 256 && NGW == 2048;
#if HYB_SLIDE
    { const v4u zero = (v4u){0u, 0u, 0u, 0u};
      for (int wi = gw; wi < (MT / 9) * 2; wi += NGW) {
        const int blk = wi >> 1, hf = wi & 1, r0 = blk * 9, c0 = hf * 512 + lane * 8;
        const f32x4 w0a = *(const f32x4*)(conv_w + c0), w0b = *(const f32x4*)(conv_w + c0 + 4);
        const f32x4 w1a = *(const f32x4*)(conv_w + 1024 + c0), w1b = *(const f32x4*)(conv_w + 1024 + c0 + 4);
        const f32x4 w2a = *(const f32x4*)(conv_w + 2048 + c0), w2b = *(const f32x4*)(conv_w + 2048 + c0 + 4);
        const bf16* ub = U + (size_t)r0 * U_LD + c0;
        v4u gP = zero, uP = zero;
        if (r0 > 0) { gP = *(const v4u*)(ub - U_LD + 1024); uP = *(const v4u*)(ub - U_LD + 2048); }
        v4u gC = *(const v4u*)(ub + 1024), uC = *(const v4u*)(ub + 2048), bC = *(const v4u*)ub;
        v4u gN = *(const v4u*)(ub + U_LD + 1024), uN = *(const v4u*)(ub + U_LD + 2048), bN = *(const v4u*)(ub + U_LD);
#pragma unroll
        for (int i = 0; i < 9; ++i) {
            const int row = r0 + i, s = row % SROW;
            v4u gNN = zero, uNN = zero, bNN = zero;
            if (i + 2 < 10 && row + 2 < MT) { const bf16* un = ub + (size_t)(i + 2) * U_LD; gNN = *(const v4u*)(un + 1024); uNN = *(const v4u*)(un + 2048); if (i + 2 < 9) bNN = *(const v4u*)un; }
            const bool has_p = (s != 0 && s != CTXL), has_n = (s != CTXL - 1 && s != SROW - 1);
            float fb[8], fc0[8], fu0[8], fc1[8], fu1[8], fc2[8], fu2[8], y[8];
            unpack8(bC, fb); unpack8(has_p ? gP : zero, fc0); unpack8(has_p ? uP : zero, fu0); unpack8(gC, fc1); unpack8(uC, fu1); unpack8(has_n ? gN : zero, fc2); unpack8(has_n ? uN : zero, fu2);
#pragma unroll
            for (int e = 0; e < 4; ++e) { y[e] = fb[e] * ((fc0[e] * fu0[e]) * w0a[e] + (fc1[e] * fu1[e]) * w1a[e] + (fc2[e] * fu2[e]) * w2a[e]);
                y[4 + e] = fb[4 + e] * ((fc0[4 + e] * fu0[4 + e]) * w0b[e] + (fc1[4 + e] * fu1[4 + e]) * w1b[e] + (fc2[4 + e] * fu2[4 + e]) * w2b[e]); }
            if (AO_IMG) *(v4u*)((char*)AO + pg8::img_off(row, c0, DM)) = pack8(y); else *(v4u*)(AO + (size_t)row * DM + c0) = pack8(y);
            gP = gC; uP = uC; gC = gN; uC = uN; bC = bN; gN = gNN; uN = uNN; bN = bNN;
        }
      }
    }
#else
    if (part & 1) {
    const v4u zero = (v4u){0u, 0u, 0u, 0u};
#define HT_LOAD(it_, GB, GC0, U0, GC1, U1, GC2, U2) do { const int row_ = (it_) >> 1, c0_ = ((it_) & 1) * 512 + lane * 8, s_ = row_ % SROW; \
        const bf16* ur_ = U + (size_t)row_ * U_LD + c0_; GB = *(const v4u*)ur_; GC1 = *(const v4u*)(ur_ + 1024); U1 = *(const v4u*)(ur_ + 2048); \
        GC0 = zero; U0 = zero; GC2 = zero; U2 = zero; \
        if (s_ != 0 && s_ != CTXL) { GC0 = *(const v4u*)(ur_ - U_LD + 1024); U0 = *(const v4u*)(ur_ - U_LD + 2048); } \
        if (s_ != CTXL - 1 && s_ != SROW - 1) { GC2 = *(const v4u*)(ur_ + U_LD + 1024); U2 = *(const v4u*)(ur_ + U_LD + 2048); } } while (0)
    v4u ngb = zero, ngc0 = zero, nu0 = zero, ngc1 = zero, nu1 = zero, ngc2 = zero, nu2 = zero;
    { const int it0_ = blm ? gw * 18 : gw; if (it0_ < MT * 2) HT_LOAD(it0_, ngb, ngc0, nu0, ngc1, nu1, ngc2, nu2); }
    for (int n_ = 0; n_ < (MT * 2 + NGW - 1) / NGW; ++n_) {
        const int it = blm ? gw * 18 + n_ : gw + n_ * NGW; if (it >= MT * 2) break;
        const int row = it >> 1, c0 = (it & 1) * 512 + lane * 8;
        const v4u gb = ngb, gc0 = ngc0, u0 = nu0, gc1 = ngc1, u1 = nu1, gc2 = ngc2, u2 = nu2;
        { const int itn = blm ? gw * 18 + n_ + 1 : gw + (n_ + 1) * NGW; if (n_ + 1 < (MT * 2 + NGW - 1) / NGW && itn < MT * 2) HT_LOAD(itn, ngb, ngc0, nu0, ngc1, nu1, ngc2, nu2); }
        float fb[8], fc0[8], fu0[8], fc1[8], fu1[8], fc2[8], fu2[8], y[8];
        unpack8(gb, fb); unpack8(gc0, fc0); unpack8(u0, fu0); unpack8(gc1, fc1); unpack8(u1, fu1); unpack8(gc2, fc2); unpack8(u2, fu2);
        const f32x4 w0a = *(const f32x4*)(conv_w + c0), w0b = *(const f32x4*)(conv_w + c0 + 4);
        const f32x4 w1a = *(const f32x4*)(conv_w + 1024 + c0), w1b = *(const f32x4*)(conv_w + 1024 + c0 + 4);
        const f32x4 w2a = *(const f32x4*)(conv_w + 2048 + c0), w2b = *(const f32x4*)(conv_w + 2048 + c0 + 4);
#pragma unroll
        for (int e = 0; e < 4; ++e) { y[e] = fb[e] * ((fc0[e] * fu0[e]) * w0a[e] + (fc1[e] * fu1[e]) * w1a[e] + (fc2[e] * fu2[e]) * w2a[e]);
            y[4 + e] = fb[4 + e] * ((fc0[4 + e] * fu0[4 + e]) * w0b[e] + (fc1[4 + e] * fu1[4 + e]) * w1b[e] + (fc2[4 + e] * fu2[4 + e]) * w2b[e]); }
        if (AO_IMG) *(v4u*)((char*)AO + pg8::img_off(row, c0, DM)) = pack8(y); else *(v4u*)(AO + (size_t)row * DM + c0) = pack8(y);
    }
#undef HT_LOAD
    }
#endif
    if (part & 2) {
    v4u kraw[5];
#pragma unroll
    for (int n_ = 0; n_ < 5; ++n_) {
        const int sub = lane >> 4, ch = lane & 15, g = sub & 1;
        int row; bool okr;
        if (blm) { row = gw * 9 + n_ * 2 + (sub >> 1); okr = (n_ * 2 + (sub >> 1)) < 9; }
        else { const int it = gw + n_ * NGW; row = it * 2 + (sub >> 1); okr = it < MT / 2; }
        if (!okr) row = gw * 9;
        kraw[n_] = *(const v4u*)(U + (size_t)row * U_LD + 4096 + g * 128 + ch * 8); }
#pragma unroll
    for (int n_ = 0; n_ < 5; ++n_) {
        const int sub = lane >> 4, ch = lane & 15, g = sub & 1;
        int row; bool okr;
        if (blm) { row = gw * 9 + n_ * 2 + (sub >> 1); okr = (n_ * 2 + (sub >> 1)) < 9; }
        else { const int it = gw + n_ * NGW; row = it * 2 + (sub >> 1); okr = it < MT / 2; }
        if (!okr) row = gw * 9;
        const int s = row % SROW;
        bf16* kp = U + (size_t)row * U_LD + 4096 + g * 128 + ch * 8;
        float y[8]; unpack8(kraw[n_], y);
        float ss = 0.f;
#pragma unroll
        for (int e = 0; e < 8; ++e) ss += y[e] * y[e];
        ss += __shfl_xor(ss, 1); ss += __shfl_xor(ss, 2); ss += __shfl_xor(ss, 4); ss += __shfl_xor(ss, 8);
        const float rstd = 1.0f / sqrtf(ss * (1.0f / 128.0f) + EPS);
        const f32x4 g0 = *(const f32x4*)(k_gain + ch * 8), g1 = *(const f32x4*)(k_gain + ch * 8 + 4);
#pragma unroll
        for (int e = 0; e < 4; ++e) { y[e] = y[e] * rstd * g0[e]; y[4 + e] = y[4 + e] * rstd * g1[e]; }
        if (s >= CTXL) { const int t = s - CTXL; const f32x4 c = *(const f32x4*)(cosA + t * 64 + ch * 4), sn = *(const f32x4*)(sinA + t * 64 + ch * 4);
#pragma unroll
            for (int p = 0; p < 4; ++p) { const float x0 = y[2 * p], x1 = y[2 * p + 1]; y[2 * p] = x0 * c[p] - x1 * sn[p]; y[2 * p + 1] = x0 * sn[p] + x1 * c[p]; } }
        if (okr) *(v4u*)kp = pack8(y);
    }
    }
}

__device__ __forceinline__ void mla_thin(Frame& F, const float* q_gain, const float* kv_gain) {
    FRESH_LANE(lane); const int tid = F.wave * 64 + lane; (void)tid;
    const int gw = F.vcu * NWAVES + F.wave, NGW = F.G * NWAVES;
    bf16* CD = BATCH_LOCAL ? (bf16*)(F.ws + WS_H) + MLA_KVW : (bf16*)(F.ws + WS_CD);
    const float* cosM = (const float*)(F.ws + WS_ROPE) + 2 * SEQL * 64; const float* sinM = cosM + SEQL * 32;
    const bool blm = BATCH_LOCAL && F.G == 256;
    const v4u zero = (v4u){0u, 0u, 0u, 0u};
#define MT_LOAD(row_, A0, A1, KV, KR) do { const bf16* c_ = CD + (size_t)(row_) * CD_LD; A0 = *(const v4u*)(c_ + lane * 8); A1 = lane < 32 ? *(const v4u*)(c_ + 512 + lane * 8) : zero; \
        KV = *(const v4u*)(c_ + 768 + lane * 8); KR = lane < 8 ? *(const v4u*)(c_ + 1280 + lane * 8) : zero; } while (0)
    v4u na0 = zero, na1 = zero, nkv = zero, nkr = zero;
    { const int row0_ = blm ? gw * 9 : gw; if (row0_ < MT) MT_LOAD(row0_, na0, na1, nkv, nkr); }
    for (int n_ = 0; n_ < (MT + NGW - 1) / NGW; ++n_) {
        const int row = blm ? gw * 9 + n_ : gw + n_ * NGW; if (row >= MT) break;
        bf16* cd = CD + (size_t)row * CD_LD; const int s = row % SROW;
        const v4u a0 = na0, a1 = na1, kv = nkv, kr = nkr;
        { const int rown = blm ? gw * 9 + n_ + 1 : gw + (n_ + 1) * NGW; if (n_ + 1 < (MT + NGW - 1) / NGW && rown < MT) MT_LOAD(rown, na0, na1, nkv, nkr); }
        float y0[8], y1[8], yk[8]; unpack8(a0, y0); unpack8(a1, y1); unpack8(kv, yk);
        float sq = 0.f, sk = 0.f;
#pragma unroll
        for (int e = 0; e < 8; ++e) { sq += y0[e] * y0[e] + y1[e] * y1[e]; sk += yk[e] * yk[e]; }
        const float rq = 1.0f / sqrtf(wave_sum(sq) * (1.0f / 768.0f) + EPS), rk = 1.0f / sqrtf(wave_sum(sk) * (1.0f / 512.0f) + EPS);
        { const f32x4 g0 = *(const f32x4*)(q_gain + lane * 8), g1 = *(const f32x4*)(q_gain + lane * 8 + 4);
#pragma unroll
          for (int e = 0; e < 4; ++e) { y0[e] = y0[e] * rq * g0[e]; y0[4 + e] = y0[4 + e] * rq * g1[e]; }
          *(v4u*)(cd + lane * 8) = pack8(y0); }
        if (lane < 32) { const f32x4 g0 = *(const f32x4*)(q_gain + 512 + lane * 8), g1 = *(const f32x4*)(q_gain + 512 + lane * 8 + 4);
#pragma unroll
          for (int e = 0; e < 4; ++e) { y1[e] = y1[e] * rq * g0[e]; y1[4 + e] = y1[4 + e] * rq * g1[e]; }
          *(v4u*)(cd + 512 + lane * 8) = pack8(y1); }
        { const f32x4 g0 = *(const f32x4*)(kv_gain + lane * 8), g1 = *(const f32x4*)(kv_gain + lane * 8 + 4);
#pragma unroll
          for (int e = 0; e < 4; ++e) { yk[e] = yk[e] * rk * g0[e]; yk[4 + e] = yk[4 + e] * rk * g1[e]; }
          *(v4u*)(cd + 768 + lane * 8) = pack8(yk); }
        if (lane < 8 && s >= CTXL) { const int t = s - CTXL; float yr[8]; unpack8(kr, yr);
            const f32x4 c = *(const f32x4*)(cosM + t * 32 + lane * 4), sn = *(const f32x4*)(sinM + t * 32 + lane * 4);
#pragma unroll
            for (int p = 0; p < 4; ++p) { const float x0 = yr[2 * p], x1 = yr[2 * p + 1]; yr[2 * p] = x0 * c[p] - x1 * sn[p]; yr[2 * p + 1] = x0 * sn[p] + x1 * c[p]; }
            *(v4u*)(cd + 1280 + lane * 8) = pack8(yr); }
    }
#undef MT_LOAD
}

#ifndef GU_SKEW_US
#define GU_SKEW_US 0
#endif
__device__ __forceinline__ void skew_start(int nwg, int G, int c, int max_us) {
    if (max_us <= 0) return;
    const int rem = nwg % G;
    if (rem == 0 || c < rem) return;
    const unsigned ticks = (unsigned)(((long)(c - rem) * max_us * 100) / (G - rem));
    const unsigned long long t0 = __builtin_amdgcn_s_memrealtime();
    while ((unsigned)(__builtin_amdgcn_s_memrealtime() - t0) < ticks) __builtin_amdgcn_s_sleep(16);
}

__device__ __forceinline__ void xcc_skew_start(int step_ns) {
    if (step_ns <= 0) return;
    const unsigned x = (unsigned)__builtin_amdgcn_s_getreg((3 << 11) | 20) & 0xFu;
    const unsigned ticks = x * (unsigned)step_ns / 10u;
    const unsigned long long t0 = __builtin_amdgcn_s_memrealtime();
    while ((unsigned)(__builtin_amdgcn_s_memrealtime() - t0) < ticks) __builtin_amdgcn_s_sleep(4);
}

__device__ __forceinline__ void ra_stagger_start(int nwg, int c, int step_crit_ns, int step_free_ns) {
    const int Rr = (nwg >> 5) & 7, x = c & 7;
    if (Rr == 0) return;
    const int ns = x < Rr ? x * step_crit_ns : Rr * step_crit_ns + (x - Rr) * step_free_ns;
    if (ns <= 0) return;
    const unsigned ticks = (unsigned)ns / 10u;
    const unsigned long long t0 = __builtin_amdgcn_s_memrealtime();
    while ((unsigned)(__builtin_amdgcn_s_memrealtime() - t0) < ticks) __builtin_amdgcn_s_sleep(4);
}
__global__ void __launch_bounds__(NWAVES * 64, 2) mk_fwd(Args args) {
    extern __shared__ __attribute__((aligned(16))) unsigned char lds_raw[];
    Frame F;
    F.lds = (LAS unsigned char*)lds_raw;
    F.MISC = (volatile LAS unsigned*)(F.lds + MISC_OFF);
    F.wave = __builtin_amdgcn_readfirstlane((int)threadIdx.x >> 6);
    F.G = gridDim.x; { const int bx = blockIdx.x; F.vcu = (F.G % 8 == 0) ? (bx % 8) * (F.G / 8) + bx / 8 : bx; }
    F.ws = args.ws;
    unsigned char* ws = args.ws;
    { FRESH_LANE(l0); for (int u = F.wave * 64 + l0; u < (LDS_BYTES - LDSCTL_OFF) / 4; u += NWAVES * 64) ((LAS unsigned*)(F.lds + LDSCTL_OFF))[u] = 0u; }
    __syncthreads();
    XcdBarrier bar; bar.bar = (unsigned*)(ws + WS_CTL) + CW_BAR; bar.x = 0; bar.st = nullptr;
    if (!MK_PER_PHASE) { FRESH_LANE(l1); bar = xcd_barrier_post((unsigned*)(ws + WS_CTL) + CW_BAR, F.MISC + 8, F.wave == 0 && l1 == 0); }
    const int lo = args.ph_lo, hi = args.ph_hi;
    int pid = 0;
#define IN_PH() (lo <= pid && pid < hi)
#ifndef CONV_IN_ATT
#define CONV_IN_ATT 0
#endif
#ifndef GU_STAG_CRIT_NS
#define GU_STAG_CRIT_NS 2000
#endif
#ifndef GU_STAG_FREE_NS
#define GU_STAG_FREE_NS 5000
#endif
#ifndef GU_XSKEW_NS
#define GU_XSKEW_NS 0
#endif
#ifndef MLA_SDEPTH
#define MLA_SDEPTH 1
#endif
#ifndef NORM_RM_PROBE
#define NORM_RM_PROBE 0
#endif
#ifndef MLA_WGM
#define MLA_WGM 8
#endif
#ifndef HIN_WGM
#define HIN_WGM 8
#endif
#ifndef OUT_WGM
#define OUT_WGM 4
#endif
#ifndef REPMASK
#define REPMASK 0
#endif
#define NREP(bit) (((REPMASK >> (bit)) & 1) ? 2 : 1)
#define REPBAR(bit, it) do { if (((REPMASK >> (bit)) & 1) && (it) == 0) { FRESH_LANE(lr_); xcd_barrier(bar, F.wave == 0 && lr_ == 0); } } while (0)
    const bool BL = BATCH_LOCAL && F.G == 256;
#ifndef PROBE_BAR
#define PROBE_BAR 0
#endif
#define SEAM() do { if (lo <= pid && pid + 1 < hi) { FRESH_LANE(lb_); if (BL && pid >= 2) xcd_barrier_local(bar, F.wave == 0 && lb_ == 0); else xcd_barrier(bar, F.wave == 0 && lb_ == 0); \
        } ++pid; } while (0)

    bf16* XN = (bf16*)(ws + WS_XN); bf16* AO = (bf16*)(ws + WS_AO); bf16* HB = (bf16*)(ws + WS_H); xres_t* X = (xres_t*)(ws + WS_X); float* MODV = (float*)(ws + WS_MODV);
    const int bid = (int)blockIdx.x;

    if (IN_PH()) for (int rep = 0; rep < NREP(0); ++rep) { p0_prologue(F, args); REPBAR(0, rep); }
    SEAM();
#if PROBE_BAR
    { FRESH_LANE(lq_); for (int pb_ = 0; pb_ < PROBE_BAR; ++pb_) xcd_barrier(bar, F.wave == 0 && lq_ == 0); }
#endif
    if (IN_PH()) { FRESH_LANE(l2_); mod_gemv_reduce(F, args, 0, (F.vcu * NWAVES + F.wave) * 64 + l2_, F.G * NWAVES * 64); mod_gemv_reduce(F, args, 1, (F.vcu * NWAVES + F.wave) * 64 + l2_, F.G * NWAVES * 64); }
    SEAM();

#pragma unroll 1
    for (int layer = 0; layer < 2; ++layer) {
        const float* modL = MODV + (size_t)layer * 9 * NMODC;
#pragma unroll 1
        for (int f = 0; f < 2; ++f) {
            const bool lat_only = (layer == 1 && f == 1);
            const int nMv = lat_only ? 64 : 72, mmode = lat_only ? 1 : 0;
            if (IN_PH()) for (int rep = 0; rep < NREP(4); ++rep) {
#if XT
                if (layer == 0 && f == 0) norm_phase(F, args.in[6], modL, 0, 1, false, false, args.in[0], args.in[2]);
                else norm_band_phase(F, args.in[f == 0 ? 6 : 8] + layer * DM, modL, f * 6 + 0, f * 6 + 1, lat_only, (layer + f) == 1, nullptr);
#else
#if XH && NORM16 && NORM_D2
                if (layer == 0 && f == 0) norm_phase(F, args.in[6], modL, 0, 1, false, false, args.in[0], args.in[2]);
                else norm_phase_d2(F, args.in[f == 0 ? 6 : 8] + layer * DM, modL, f * 6 + 0, f * 6 + 1, lat_only, (layer + f) == 1, nullptr);
#else
                norm_phase(F, args.in[f == 0 ? 6 : 8] + layer * DM, modL, f * 6 + 0, f * 6 + 1, lat_only, (layer + f) == 1 && !(NORM_RM_PROBE && rep == 0 && NREP(4) == 2), (layer == 0 && f == 0) ? args.in[0] : nullptr, (layer == 0 && f == 0) ? args.in[2] : nullptr, NORM_RM_PROBE && rep == 0 && NREP(4) == 2);
#endif
#endif
                REPBAR(4, rep); }
            SEAM();
            if (IN_PH()) for (int rep = 0; rep < NREP(1); ++rep) {
                REPBAR(1, rep ^ 1);
                pg8::Gemm g{XN, (const bf16*)(ws + WS_WGU + (size_t)(layer * 2 + f) * SZ_WGU), DM, DM, DM / 64};
#ifndef GU_WGM
#define GU_WGM 8
#endif
#ifdef PROBE_HALF
                if (layer == 0 && f == 0) {
                    const int grp = (bid >> 3) & 1, rk = ((bid >> 4) << 3) | (bid & 7);
                    if (grp == 0) { pg8::Sched S; S.init(nMv, 2 * DFF / 256, 1, 0, mmode, F.G / 2, rk, GU_WGM);
                        pg8::EpiSwiGLU<IMG_H> E{HB, DFF};
                        pg8::gemm_phase<pg8::EpiSwiGLU<IMG_H>, IMG_H, IMG_H>(F.lds + RING_OFF, g, S, E, F.wave); }
#if PROBE_HALF == 2
                    else { FRESH_LANE(ls_); const int gw2 = rk * NWAVES + F.wave, NGW2 = (F.G / 2) * NWAVES;
                        const float* Xs = (const float*)(ws + WS_X); float* Os = (float*)(ws + WS_TOTAL + 16 * MiB);
                        for (int rep_ = 0; rep_ < 10; ++rep_)
                            for (int lr = gw2; lr < MT; lr += NGW2) { const f32x4* xr = (const f32x4*)(Xs + (size_t)lr * DM) + ls_; f32x4 v_[8]; f32x4 acc_ = (f32x4){0.f, 0.f, 0.f, 0.f};
#pragma unroll
                                for (int j = 0; j < 8; ++j) v_[j] = xr[64 * j];
#pragma unroll
                                for (int j = 0; j < 8; ++j) acc_ += v_[j];
                                f32x4* o_ = (f32x4*)(Os + (size_t)lr * (DM / 2)) + ls_;
#pragma unroll
                                for (int j = 0; j < 4; ++j) o_[64 * j] = acc_ * (float)(j + rep_); } }
#endif
                } else
#endif
                {
                pg8::Sched S; S.init(nMv, 2 * DFF / 256, 1, 0, mmode, F.G, bid, GU_WGM);
                skew_start(S.nwg, F.G, bid, GU_SKEW_US);
                xcc_skew_start(GU_XSKEW_NS);
                if (S.ra) ra_stagger_start(S.nwg, bid, GU_STAG_CRIT_NS, GU_STAG_FREE_NS);
#ifdef PROBE_GU
#if PROBE_GU >= 3
                if (rep == 0 && NREP(1) == 2) { pg8::EpiSwiGLUProbe<PROBE_GU> E{(bf16*)(ws + WS_TOTAL + 16 * MiB), DFF}; pg8::gemm_phase<pg8::EpiSwiGLUProbe<PROBE_GU>, IMG_H, IMG_H>(F.lds + RING_OFF, g, S, E, F.wave); } else
#else
                if (rep == 0 && NREP(1) == 2) { pg8::EpiNull E{}; pg8::gemm_phase<pg8::EpiNull, IMG_H, IMG_H>(F.lds + RING_OFF, g, S, E, F.wave); } else
#endif
#endif
                { pg8::EpiSwiGLU<IMG_H> E{HB, DFF};
                pg8::gemm_phase<pg8::EpiSwiGLU<IMG_H>, IMG_H, IMG_H>(F.lds + RING_OFF, g, S, E, F.wave); }
                }
            }
            SEAM();
            if (IN_PH()) {
                const bf16* Wd = (const bf16*)(ws + WS_WD + (size_t)(layer * 2 + f) * SZ_WD);
#ifndef DOWN_WGM
#define DOWN_WGM 4
#endif
                { pg8::Gemm g{HB, Wd, DFF, DFF, DFF / 64};
                  pg8::Sched S; S.init(64, DM / 256, 1, 0, 1, F.G, bid, DOWN_WGM);
                  pg8::EpiResid<true, false> E{X, modL + (f * 6 + 2) * DM, nullptr, (layer == 0 && f == 0) ? args.in[0] : nullptr, args.in[2], (XT && layer == 1 && f == 1) ? (xres_t*)(ws + WS_XN) : nullptr};
                  pg8::gemm_phase<pg8::EpiResid<true, false>, IMG_H, IMG_H, DOWN_KREV>(F.lds + RING_OFF, g, S, E, F.wave); }
#ifdef PROBE_DOWN
                { FRESH_LANE(lp_); xcd_barrier(bar, F.wave == 0 && lp_ == 0); }
#if PROBE_DOWN == 2
                { pg8::Gemm g{HB, Wd, DFF, DFF, DFF / 64};
                  pg8::Sched S; S.init(64, DM / 256, 1, 0, 1, F.G, bid);
                  pg8::EpiResid<true, false> E{(xres_t*)(ws + WS_TOTAL + 16 * MiB), modL + (f * 6 + 2) * DM, nullptr, nullptr, nullptr, nullptr};
                  pg8::gemm_phase<pg8::EpiResid<true, false>, IMG_H, IMG_H>(F.lds + RING_OFF, g, S, E, F.wave); }
#elif PROBE_DOWN == 5
                { pg8::Gemm g{HB, Wd, DFF, DFF, DFF / 64};
                  pg8::Sched S; S.init(64, DM / 256, 1, 0, 1, F.G, bid);
                  pg8::EpiStoreImg E{(bf16*)(ws + WS_END), DM};
                  pg8::gemm_phase<pg8::EpiStoreImg, IMG_H, IMG_H>(F.lds + RING_OFF, g, S, E, F.wave); }
#elif PROBE_DOWN == 6
                { pg8::Gemm g{HB, Wd, DFF, DFF, DFF / 64};
                  pg8::Sched S; S.init(64, DM / 256, 1, 0, 1, F.G, bid);
                  pg8::EpiStoreSwap E{(bf16*)(ws + WS_END), DM};
                  pg8::gemm_phase<pg8::EpiStoreSwap, IMG_H, IMG_H>(F.lds + RING_OFF, g, S, E, F.wave); }
#elif PROBE_DOWN == 4
                { pg8::Gemm g{HB, Wd, DFF, DFF, DFF / 64};
                  pg8::Sched S; S.init(64, DM / 256, 1, 0, 1, F.G, bid);
                  pg8::EpiNull E{};
                  pg8::gemm_phase<pg8::EpiNull, IMG_H, IMG_H>(F.lds + RING_OFF, g, S, E, F.wave); }
#else
                { pg8::Gemm g{HB, Wd, DFF, DFF, DFF / 64};
                  pg8::Sched S; S.init(64, DM / 256, 1, 0, 1, F.G, bid); S.probe_alias = (PROBE_DOWN == 3);
                  pg8::EpiStore E{(bf16*)(ws + WS_END), DM};
                  pg8::gemm_phase<pg8::EpiStore, IMG_H, IMG_H>(F.lds + RING_OFF, g, S, E, F.wave); }
#endif
#endif
                if (!lat_only) {
                  pg8::Gemm g{HB, Wd, DFF, DFF, DFF / 64 / 4};
                  pg8::Sched S; S.init(8, DM / 256, 4, DFF / 4, 2, F.G, bid);
                  pg8::EpiResid<true, true> E{X, modL + (f * 6 + 2) * DM, (float*)(ws + WS_P), nullptr, nullptr, nullptr};
                  pg8::gemm_phase<pg8::EpiResid<true, true>, IMG_H, IMG_H, DOWN_KREV>(F.lds + RING_OFF, g, S, E, F.wave); }
            }
            SEAM();
            if (f == 0) {
                if (IN_PH()) for (int rep = 0; rep < NREP(4); ++rep) {
#if XT
                    norm_band_phase(F, args.in[7] + layer * DM, modL, 3, 4, false, true, layer == 0 ? args.in[2] : nullptr);
#else
#if XH && NORM16 && NORM_D2
                    norm_phase_d2(F, args.in[7] + layer * DM, modL, 3, 4, false, true, layer == 0 ? args.in[2] : nullptr);
#else
                    norm_phase(F, args.in[7] + layer * DM, modL, 3, 4, false, true, nullptr, layer == 0 ? args.in[2] : nullptr);
#endif
#endif
                    REPBAR(4, rep); }
                SEAM();
                if (layer == 0) {
#if HIN_DEFER
                    if (IN_PH()) for (int rp5 = 0; rp5 < NREP(5); ++rp5) { REPBAR(5, rp5 ^ 1);
                        pg8::Gemm g{XN, (const bf16*)(ws + WS_WHIN), DM, DM, DM / 64};
                        pg8::EpiStore E{HB, U_LD};
                        const int nmain = 72 * 17, nb_ = nmain % F.G, nfill = (nb_ == 0) ? 0 : ((F.G - nb_) < 72 ? (F.G - nb_) : 72);
                        { pg8::Sched S; S.init(72, 17, 1, 0, 0, F.G, bid);
                          pg8::gemm_phase<pg8::EpiStore, IMG_H, IMG_H>(F.lds + RING_OFF, g, S, E, F.wave); }
                        if (nfill > 0 && bid >= nb_) { pg8::Sched S; S.init(nfill, 1, 1, 0, 0, nfill, bid - nb_, pg8::WGM, 0, 17);
                          pg8::gemm_phase<pg8::EpiStore, IMG_H, IMG_H>(F.lds + RING_OFF, g, S, E, F.wave); }
                    }
                    SEAM();
                    if (IN_PH()) {
                        const int nmain = 72 * 17, nb_ = nmain % F.G, nfill = (nb_ == 0) ? 0 : ((F.G - nb_) < 72 ? (F.G - nb_) : 72), nrest = 72 - nfill;
                        const int ngemm = nrest < F.G / 2 ? nrest : 0;
                        if (bid < ngemm) { pg8::Gemm g{XN, (const bf16*)(ws + WS_WHIN), DM, DM, DM / 64}; pg8::EpiStore E{HB, U_LD};
                            pg8::Sched S; S.init(nrest, 1, 1, 0, 0, ngemm, bid, pg8::WGM, nfill, 17);
                            pg8::gemm_phase<pg8::EpiStore, IMG_H, IMG_H>(F.lds + RING_OFF, g, S, E, F.wave); }
                        else { if (ngemm == 0 && nrest > 0) { pg8::Gemm g{XN, (const bf16*)(ws + WS_WHIN), DM, DM, DM / 64}; pg8::EpiStore E{HB, U_LD};
                                   pg8::Sched S; S.init(nrest, 1, 1, 0, 0, F.G, bid, pg8::WGM, nfill, 17);
                                   pg8::gemm_phase<pg8::EpiStore, IMG_H, IMG_H>(F.lds + RING_OFF, g, S, E, F.wave); }
                               hyb_thin(F, args.in[16], args.in[18], (bid - ngemm) * NWAVES + F.wave, (F.G - ngemm) * NWAVES); }
                    }
                    SEAM();
#else
                    if (IN_PH()) for (int rp5 = 0; rp5 < NREP(5); ++rp5) { REPBAR(5, rp5 ^ 1);
                        pg8::Gemm g{XN, (const bf16*)(ws + WS_WHIN), DM, DM, DM / 64};
                        pg8::Sched S; S.init(72, HYB_IN / 256, 1, 0, 0, F.G, bid, HIN_WGM);
                        pg8::EpiStore E{HB, U_LD};
                        pg8::gemm_phase<pg8::EpiStore, IMG_H, IMG_H>(F.lds + RING_OFF, g, S, E, F.wave);
                    }
                    SEAM();
                    if (IN_PH()) hyb_thin(F, args.in[16], args.in[18], F.vcu * NWAVES + F.wave, F.G * NWAVES, CONV_IN_ATT ? 2 : 3);
                    SEAM();
#endif
                    if (IN_PH()) {
                        const float* cosA = (const float*)(ws + WS_ROPE); const float* sinA = cosA + SEQL * 64;
                        for (int rep = 0; rep < NREP(2); ++rep) { REPBAR(2, rep ^ 1);
                        for (int L = BL ? (bid >> 3) : bid; L < (BL ? 72 : 512 + 64); L += (BL ? (F.G >> 3) : F.G)) {
                            att::AttnArgs a;
                            int b, hq, row0;
                            if (BL) { b = bid & 7;
                                if (L < 64) { hq = L >> 3; const int qb = L & 7; row0 = b * SROW + CTXL + qb * 256; a.seq = SROW; a.t0 = qb * 256; }
                                else { hq = L - 64; row0 = b * SROW; a.seq = CTXL; a.t0 = -1; } }
                            else
                            if (L < 512) { const int s_ = (L & 255) >> 3, pair = (L >> 8) * 8 + (L & 7), qb = s_ & 7; b = pair >> 1; hq = (pair & 1) * 4 + (s_ >> 3); row0 = b * SROW + CTXL + qb * 256; a.seq = SROW; a.t0 = qb * 256; }
                            else { const int l2 = L - 512; b = l2 >> 3; hq = l2 & 7; row0 = b * SROW; a.seq = CTXL; a.t0 = -1; }
                            const int g = hq >> 2;
                            a.Q = HB + (size_t)row0 * U_LD + 3072 + hq * 128; a.K = HB + (size_t)(b * SROW) * U_LD + 4096 + g * 128; a.KR = nullptr; a.V = HB + (size_t)(b * SROW) * U_LD + 4352 + g * 128;
                            a.O = AO_IMG ? AO : AO + (size_t)row0 * DM + 1024 + hq * 128; a.orow0 = row0; a.ocol0 = 1024 + hq * 128;
                            a.ldq = U_LD; a.ldk = U_LD; a.ldkr = 0; a.ldv = U_LD; a.ldo = DM; a.cosT = cosA; a.sinT = sinA; a.qgain = args.in[17];
                            if (ATT_DMA) att::attn_unit_dma<0, ATT_STAG>(a, F.lds + RING_OFF, F.wave); else att::attn_unit<0, 2>(a, F.lds + RING_OFF, F.wave);
                        }
#if CONV_IN_ATT
                        { const int nshort = (512 + 64) % F.G;
                          if (!BL && nshort > 0 && nshort < F.G) { if (bid >= nshort) hyb_thin(F, args.in[16], args.in[18], (bid - nshort) * NWAVES + F.wave, (F.G - nshort) * NWAVES, 1); }
                          else hyb_thin(F, args.in[16], args.in[18], F.vcu * NWAVES + F.wave, F.G * NWAVES, 1); }
#endif
                        }
                    }
                    SEAM();
                    if (IN_PH()) {
                        { pg8::Gemm g{AO, (const bf16*)(ws + WS_WHOUT), DM, DM, DM / 64};
                          pg8::Sched S; S.init(64, DM / 256, 1, 0, 1, F.G, bid, OUT_WGM);
                          pg8::EpiResid<false, false> E{X, modL + 5 * DM, nullptr, nullptr, nullptr, nullptr};
                          pg8::gemm_phase<pg8::EpiResid<false, false>, AO_IMG != 0, IMG_H>(F.lds + RING_OFF, g, S, E, F.wave); }
                        { pg8::Gemm g{AO, (const bf16*)(ws + WS_WHOUT), DM, DM, DM / 64 / 4};
                          pg8::Sched S; S.init(8, DM / 256, 4, DM / 4, 2, F.G, bid);
                          pg8::EpiResid<false, true> E{X, modL + 5 * DM, (float*)(ws + WS_P), nullptr, nullptr, nullptr};
                          pg8::gemm_phase<pg8::EpiResid<false, true>, AO_IMG != 0, IMG_H>(F.lds + RING_OFF, g, S, E, F.wave); }
                    }
                    SEAM();
                } else {
                    bf16* KV = HB; bf16* CD = BATCH_LOCAL ? HB + MLA_KVW : (bf16*)(ws + WS_CD); bf16* Q2 = (bf16*)(ws + WS_Q2);
                    if (IN_PH()) for (int rp6 = 0; rp6 < NREP(6); ++rp6) { REPBAR(6, rp6 ^ 1);
                        pg8::Gemm g{XN, (const bf16*)(ws + WS_WMDOWN), DM, DM, DM / 64};
                        pg8::Sched S; S.init(72, MLA_DP / 256, 1, 0, 0, F.G, bid, MLA_WGM);
                        pg8::EpiStore E{CD, CD_LD};
                        pg8::gemm_phase<pg8::EpiStore, IMG_H, IMG_H>(F.lds + RING_OFF, g, S, E, F.wave);
                    }
                    SEAM();
                    if (IN_PH()) mla_thin(F, args.in[21], args.in[22]);
                    SEAM();
                    if (IN_PH()) for (int rp7 = 0; rp7 < NREP(7); ++rp7) { REPBAR(7, rp7 ^ 1);
                        { pg8::Gemm g{CD, (const bf16*)(ws + WS_WMUQ), CD_LD, 768, 768 / 64};
                          pg8::Sched S; S.init(64, MLA_QW / 256, 1, 0, 1, F.G, bid, MLA_WGM);
#if Q2_IMG
                          pg8::EpiStoreImg E{Q2, MLA_QW};
                          pg8::gemm_phase<pg8::EpiStoreImg, false, IMG_H>(F.lds + RING_OFF, g, S, E, F.wave); }
#else
                          pg8::EpiStore E{Q2, MLA_QW};
                          pg8::gemm_phase<pg8::EpiStore, false, IMG_H>(F.lds + RING_OFF, g, S, E, F.wave); }
#endif
                        { pg8::Gemm g{CD + 768, (const bf16*)(ws + WS_WMUKV), CD_LD, 512, 512 / 64};
                          pg8::Sched S; S.init(72, MLA_KVW / 256, 1, 0, 0, F.G, bid, MLA_WGM);
                          pg8::EpiStore E{KV, KV_LD};
                          pg8::gemm_phase<pg8::EpiStore, false, IMG_H>(F.lds + RING_OFF, g, S, E, F.wave);
                          }
                    }
                    SEAM();
                    if (IN_PH()) {
                        const float* cosM = (const float*)(ws + WS_ROPE) + 2 * SEQL * 64; const float* sinM = cosM + SEQL * 32;
                        for (int rep = 0; rep < NREP(3); ++rep) { REPBAR(3, rep ^ 1);
                        for (int L0_ = BL ? (bid >> 3) : bid; L0_ < (BL ? 128 : 1024); L0_ += (BL ? (F.G >> 3) : F.G)) {
                            att::AttnArgs a;
                            const int L = L0_, s_ = (L & 255) >> 3, pair = (L >> 8) * 32 + (L & 7) * 4 + (s_ >> 3);
                            const int qb = BL ? (L & 7) : (s_ & 7), b = BL ? (bid & 7) : (pair >> 4), h = BL ? (L >> 3) : (pair & 15), row0 = b * SROW + CTXL + qb * 256;
                            a.Q = Q2_IMG ? Q2 : Q2 + (size_t)row0 * MLA_QW + h * 192; a.qcol0 = h * 192; a.K = KV + (size_t)(b * SROW) * KV_LD + h * 256; a.KR = CD + (size_t)(b * SROW) * CD_LD + 1280; a.V = KV + (size_t)(b * SROW) * KV_LD + h * 256 + 128;
                            a.O = AO_IMG ? AO : AO + (size_t)row0 * DM + h * 128; a.orow0 = row0; a.ocol0 = h * 128;
                            a.ldq = MLA_QW; a.ldk = KV_LD; a.ldkr = CD_LD; a.ldv = KV_LD; a.ldo = DM; a.seq = SROW; a.t0 = qb * 256; a.cosT = cosM; a.sinT = sinM; a.qgain = nullptr;
#ifdef PROBE_MLA0
                            if (rep == 0 && NREP(3) == 2) { a.O = (bf16*)(ws + WS_TOTAL + 16 * MiB) + (size_t)row0 * DM + h * 128; a.cosT = (const float*)(ws + WS_ROPE); a.sinT = a.cosT + SEQL * 64; a.qgain = args.in[17];
                                att::attn_unit<0, 2>(a, F.lds + RING_OFF, F.wave); } else
#endif
                            if (ATT_DMA) att::attn_unit_dma<1, ATT_STAG>(a, F.lds + RING_OFF, F.wave); else att::attn_unit<1, MLA_SDEPTH>(a, F.lds + RING_OFF, F.wave);
                        } }
                    }
                    SEAM();
                    if (IN_PH()) {
                        pg8::Gemm g{AO, (const bf16*)(ws + WS_WMO), DM, DM, DM / 64};
                        pg8::Sched S; S.init(64, DM / 256, 1, 0, 1, F.G, bid, OUT_WGM);
                        pg8::EpiResid<false, false> E{X, modL + 5 * DM, nullptr, nullptr, nullptr, nullptr};
                        pg8::gemm_phase<pg8::EpiResid<false, false>, AO_IMG != 0, IMG_H>(F.lds + RING_OFF, g, S, E, F.wave);
                    }
                    SEAM();
                }
            }
        }
    }
    if (IN_PH()) for (int rep = 0; rep < NREP(4); ++rep) { final_norm_phase(F, args.in[26], args.out); REPBAR(4, rep); }
#undef IN_PH
#undef SEAM
}
constexpr int N_PHASES = 2 + (3 + 1 + 4 + 3) + (3 + 1 + 5 + 3) + 1;

extern "C" void kernel_launch(void* const* d_in, const int* in_sizes, int n_in, void* d_out, int out_size, void* d_ws, size_t ws_size, hipStream_t stream) {
    static int grid = 0;
    if (grid == 0) {
        if (n_in != 27 || in_sizes[0] != NB * SEQL * DM || out_size != NB * SEQL * DM || ws_size < WS_TOTAL) {
            fprintf(stderr, "kernel_launch: shape mismatch: n_in %d in0 %d out %d ws %zu (need %zu); nothing launched\n", n_in, n_in > 0 ? in_sizes[0] : -1, out_size, ws_size, (size_t)WS_END); grid = -1; return; }
        int dev = 0, cus = 0;
        if (hipGetDevice(&dev) != hipSuccess || hipDeviceGetAttribute(&cus, hipDeviceAttributeMultiprocessorCount, dev) != hipSuccess) { fprintf(stderr, "kernel_launch: device query failed\n"); grid = -1; return; }
        if (hipFuncSetAttribute((const void*)mk_fwd, hipFuncAttributeMaxDynamicSharedMemorySize, LDS_BYTES) != hipSuccess) { fprintf(stderr, "kernel_launch: hipFuncSetAttribute failed\n"); grid = -1; return; }
        int per_cu = 0;
        if (hipOccupancyMaxActiveBlocksPerMultiprocessor(&per_cu, (const void*)mk_fwd, NWAVES * 64, LDS_BYTES) != hipSuccess || per_cu < 1) { fprintf(stderr, "kernel_launch: occupancy query reports %d workgroups per CU\n", per_cu); }
        (void)hipGetLastError();
        grid = cus;
    }
    if (grid < 0) return;
    if (hipMemsetAsync((char*)d_ws + WS_CTL, 0, CTL_ZERO_BYTES, stream) != hipSuccess) { fprintf(stderr, "kernel_launch: memset failed\n"); return; }
    Args a{};
    for (int i = 0; i < 27; ++i) a.in[i] = (const float*)d_in[i];
    a.out = (float*)d_out; a.ws = (unsigned char*)d_ws;
#if MK_PER_PHASE
    for (int p = 0; p < N_PHASES; ++p) { a.ph_lo = p; a.ph_hi = p + 1; hipLaunchKernelGGL(mk_fwd, dim3(grid), dim3(NWAVES * 64), LDS_BYTES, stream, a); }
#else
    a.ph_lo = 0; a.ph_hi = 1 << 20;
    hipLaunchKernelGGL(mk_fwd, dim3(grid), dim3(NWAVES * 64), LDS_BYTES, stream, a);
#endif
    const hipError_t le = hipPeekAtLastError();
    if (le != hipSuccess) fprintf(stderr, "kernel_launch: launch failed: %s\n", hipGetErrorName(le));
}
```
